# Optimizing an MI355X kernel written in HIP

```python
import jax
import jax.numpy as jnp
from jax import lax
import numpy as np


D_MODEL = 1024
BATCH = 16
SEQ = 2048
DEPTH = 1
DEC_BATCH = 4
DEC_SEQ = 4096
PAST_LEN = 128

N_META = 16
GLA_HEADS = 4
GLA_DK = 128
GLA_DV = 256
GLA_KEY_WIDTH = GLA_HEADS * GLA_DK
GLA_WIDTH = GLA_HEADS * GLA_DV
GLA_GATE_RANK = 16
GLA_TAU = 16.0
GLA_CHUNK = 64
MLA_HEADS = 8
MLA_D_NOPE = 128
MLA_D_ROPE = 64
MLA_D_V = 128
MLA_Q_RANK = 384
MLA_KV_RANK = 256
MLA_WIDTH = MLA_HEADS * MLA_D_V
Q_BLOCK = 128
ROPE_THETA = 10000.0
LN_EPS = 1e-5
RMS_EPS = 1e-6
DEEPNORM_ALPHA = (2 * DEPTH) ** 0.25
DEEPNORM_BETA = (8 * DEPTH) ** -0.25
IN_SPLITS = (GLA_KEY_WIDTH, GLA_KEY_WIDTH, GLA_WIDTH, GLA_WIDTH, GLA_GATE_RANK, GLA_GATE_RANK,
             MLA_Q_RANK, MLA_KV_RANK, MLA_D_ROPE, MLA_WIDTH, D_MODEL, D_MODEL)
IN_COLS = sum(IN_SPLITS)

kernel_name = 'hybrid_gla_mla_encoder'


def layer_norm(x, g, b):
    xf = x.astype(jnp.float32)
    mu = jnp.mean(xf, axis=-1, keepdims=True)
    var = jnp.mean(jnp.square(xf - mu), axis=-1, keepdims=True)
    return ((xf - mu) * lax.rsqrt(var + LN_EPS) * g.astype(jnp.float32) + b.astype(jnp.float32)).astype(x.dtype)


def rms_norm(x, g):
    xf = x.astype(jnp.float32)
    ms = jnp.mean(jnp.square(xf), axis=-1, keepdims=True)
    return (xf * lax.rsqrt(ms + RMS_EPS) * g.astype(jnp.float32)).astype(x.dtype)


def split_columns(a, sizes):
    parts, start = [], 0
    for size in sizes:
        parts.append(a[..., start:start + size])
        start += size
    return parts


def rope_tables(length):
    inv_freq = 1.0 / (ROPE_THETA ** (jnp.arange(0, MLA_D_ROPE, 2, dtype=jnp.float32) / MLA_D_ROPE))
    ang = jnp.arange(length, dtype=jnp.float32)[:, None] * inv_freq[None, :]
    return jnp.cos(ang), jnp.sin(ang)


def apply_rope(x, cos, sin):
    xf = x.astype(jnp.float32)
    x1, x2 = xf[..., :MLA_D_ROPE // 2], xf[..., MLA_D_ROPE // 2:]
    return jnp.concatenate([x1 * cos - x2 * sin, x1 * sin + x2 * cos], axis=-1).astype(x.dtype)


def gla_chunked(q, k, v, g, include_diag):
    B, T, H, _ = q.shape
    n = T // GLA_CHUNK

    def chunks(a):
        return a.astype(jnp.float32).reshape(B, n, GLA_CHUNK, H, a.shape[-1]).transpose(1, 0, 3, 2, 4)

    qc = chunks(q) * (GLA_DK ** -0.5)
    kc, vc = chunks(k), chunks(v)
    bc = jnp.cumsum(chunks(g), axis=3)
    b_last = bc[:, :, :, -1:, :]
    b_mid = bc[:, :, :, GLA_CHUNK // 2:GLA_CHUNK // 2 + 1, :]
    mask = jnp.tril(jnp.ones((GLA_CHUNK, GLA_CHUNK), dtype=bool), k=0 if include_diag else -1)
    a_intra = jnp.einsum('nbhid,nbhjd->nbhij', qc * jnp.exp(bc - b_mid), kc * jnp.exp(b_mid - bc))
    o_intra = jnp.einsum('nbhij,nbhjv->nbhiv', jnp.where(mask, a_intra, 0.0), vc)
    q_in = qc * jnp.exp(bc)
    k_dec = kc * jnp.exp(b_last - bc)
    decay = jnp.exp(b_last[:, :, :, 0, :])

    def step(state, xs):
        q_i, k_i, v_i, d_i = xs
        o_i = jnp.einsum('bhid,bhdv->bhiv', q_i, state)
        state = state * d_i[..., None] + jnp.einsum('bhjd,bhjv->bhdv', k_i, v_i)
        return state, o_i

    state0 = jnp.zeros((B, H, GLA_DK, GLA_DV), jnp.float32)
    _, o_inter = lax.scan(step, state0, (q_in, k_dec, vc, decay))
    o = o_intra + o_inter
    return o.transpose(1, 0, 3, 2, 4).reshape(B, T, H, GLA_DV)


def gla_bidirectional(q, k, v, g_fwd, g_bwd):
    pad = GLA_CHUNK - N_META
    widths = ((0, 0), (pad, 0), (0, 0), (0, 0))
    q, k, v, g_fwd, g_bwd = [jnp.pad(a, widths) for a in (q, k, v, g_fwd, g_bwd)]
    rev = lambda a: jnp.flip(a, axis=1)
    o_fwd = gla_chunked(q, k, v, g_fwd, True)
    o_bwd = rev(gla_chunked(rev(q), rev(k), rev(v), rev(g_bwd), False))
    return (o_fwd + o_bwd)[:, pad:].astype(v.dtype)


def mla_attention(q_nope, q_rope, k_nope, k_rope, v):
    B, T, H, _ = q_nope.shape
    n_blk = -(-T // Q_BLOCK)
    pad = n_blk * Q_BLOCK - T
    scale = (MLA_D_NOPE + MLA_D_ROPE) ** -0.5

    def blocks(a):
        a = jnp.pad(a, ((0, 0), (0, pad), (0, 0), (0, 0)))
        return a.reshape(B, n_blk, Q_BLOCK, H, a.shape[-1]).swapaxes(0, 1)

    def attend(qs):
        qn, qr = qs
        s = (jnp.einsum('bqhd,bkhd->bhqk', qn, k_nope, preferred_element_type=jnp.float32)
             + jnp.einsum('bqhr,bkr->bhqk', qr, k_rope, preferred_element_type=jnp.float32))
        p = jax.nn.softmax(s * scale, axis=-1).astype(v.dtype)
        return jnp.einsum('bhqk,bkhd->bqhd', p, v)

    o = lax.map(attend, (blocks(q_nope), blocks(q_rope)))
    return o.swapaxes(0, 1).reshape(B, n_blk * Q_BLOCK, H, MLA_D_V)[:, :T]


def encoder_layer(h, cos, sin, w_in, b_merge, w_gla_gate_f, b_gla_gate_f, w_gla_gate_b, b_gla_gate_b,
                  gla_norm_g, w_o_gla, q_a_norm_g, w_q_b, kv_a_norm_g, w_kv_b, w_o_mla, w_out,
                  post_ln_g, post_ln_b):
    B, L, _ = h.shape
    proj = h @ w_in
    gq, gk, gv, gr, glf, glb, cq, ckv, kr, mz, ma, mb = split_columns(proj, IN_SPLITS)

    g_f = jax.nn.log_sigmoid((glf @ w_gla_gate_f).astype(jnp.float32) + b_gla_gate_f) / GLA_TAU
    g_b = jax.nn.log_sigmoid((glb @ w_gla_gate_b).astype(jnp.float32) + b_gla_gate_b) / GLA_TAU
    heads = lambda a, d: a.reshape(B, L, -1, d)
    o_gla = gla_bidirectional(heads(gq, GLA_DK), heads(gk, GLA_DK), heads(gv, GLA_DV),
                              heads(g_f, GLA_DK), heads(g_b, GLA_DK))
    o_gla = rms_norm(o_gla, gla_norm_g).reshape(B, L, GLA_WIDTH) * jax.nn.silu(gr)
    branch_a = o_gla @ w_o_gla

    q = (rms_norm(cq, q_a_norm_g) @ w_q_b).reshape(B, L, MLA_HEADS, MLA_D_NOPE + MLA_D_ROPE)
    q_nope = q[..., :MLA_D_NOPE]
    q_rope = apply_rope(q[..., MLA_D_NOPE:], cos[:, None, :], sin[:, None, :])
    kv = (rms_norm(ckv, kv_a_norm_g) @ w_kv_b).reshape(B, L, MLA_HEADS, MLA_D_NOPE + MLA_D_V)
    k_nope, v = kv[..., :MLA_D_NOPE], kv[..., MLA_D_NOPE:]
    k_rope = apply_rope(kr, cos, sin)
    o_mla = mla_attention(q_nope, q_rope, k_nope, k_rope, v).reshape(B, L, MLA_WIDTH) * jax.nn.silu(mz)
    branch_b = o_mla @ w_o_mla

    mixed = jax.nn.sigmoid(ma + b_merge[:D_MODEL]) * branch_a + jax.nn.sigmoid(mb + b_merge[D_MODEL:]) * branch_b
    out = mixed @ w_out
    return layer_norm(DEEPNORM_ALPHA * h + out, post_ln_g, post_ln_b)


def encode(x, meta_tokens, emb_ln_g, emb_ln_b, layer_params):
    B, S, _ = x.shape
    L = N_META + S
    meta = jnp.broadcast_to(meta_tokens[None].astype(x.dtype), (B, N_META, D_MODEL))
    h = layer_norm(jnp.concatenate([meta, x], axis=1), emb_ln_g, emb_ln_b)
    cos, sin = rope_tables(L)
    for l in range(DEPTH):
        h = encoder_layer(h, cos, sin, *[p[l] for p in layer_params])
    return h[:, N_META:]


def setup_inputs(seed: int = 0) -> dict:
    key = jax.random.key(seed)
    ks = jax.random.split(key, 24)

    def nrm(k, shape, scale):
        return jax.random.normal(k, shape, jnp.float32) * scale

    def gain(k, shape):
        return 1.0 + nrm(k, shape, 0.02)

    x_prompt = nrm(ks[0], (BATCH, SEQ, D_MODEL), 1.0)
    x_sample = nrm(ks[1], (DEC_BATCH, DEC_SEQ, D_MODEL), 1.0)
    meta_tokens = nrm(ks[2], (N_META, D_MODEL), 1.0)
    emb_ln_g = gain(ks[3], (D_MODEL,))
    emb_ln_b = nrm(ks[4], (D_MODEL,), 0.02)
    v_lo = 2 * GLA_KEY_WIDTH
    w_in = nrm(ks[5], (DEPTH, D_MODEL, IN_COLS), D_MODEL ** -0.5)
    w_in = w_in.at[:, :, v_lo:v_lo + GLA_WIDTH].multiply(DEEPNORM_BETA)
    b_merge = nrm(ks[6], (DEPTH, 2 * D_MODEL), 0.02)
    w_gla_gate_f = nrm(ks[7], (DEPTH, GLA_GATE_RANK, GLA_KEY_WIDTH), GLA_GATE_RANK ** -0.5)
    b_gla_gate_f = nrm(ks[8], (DEPTH, GLA_KEY_WIDTH), 0.1)
    w_gla_gate_b = nrm(ks[9], (DEPTH, GLA_GATE_RANK, GLA_KEY_WIDTH), GLA_GATE_RANK ** -0.5)
    b_gla_gate_b = nrm(ks[10], (DEPTH, GLA_KEY_WIDTH), 0.1)
    gla_norm_g = gain(ks[11], (DEPTH, GLA_DV))
    w_o_gla = nrm(ks[12], (DEPTH, GLA_WIDTH, D_MODEL), GLA_WIDTH ** -0.5 * DEEPNORM_BETA)
    q_a_norm_g = gain(ks[13], (DEPTH, MLA_Q_RANK))
    w_q_b = nrm(ks[14], (DEPTH, MLA_Q_RANK, MLA_HEADS * (MLA_D_NOPE + MLA_D_ROPE)), MLA_Q_RANK ** -0.5)
    kv_a_norm_g = gain(ks[15], (DEPTH, MLA_KV_RANK))
    w_kv_b = nrm(ks[16], (DEPTH, MLA_KV_RANK, MLA_HEADS, MLA_D_NOPE + MLA_D_V), MLA_KV_RANK ** -0.5)
    w_kv_b = w_kv_b.at[..., MLA_D_NOPE:].multiply(DEEPNORM_BETA).reshape(
        DEPTH, MLA_KV_RANK, MLA_HEADS * (MLA_D_NOPE + MLA_D_V))
    w_o_mla = nrm(ks[17], (DEPTH, MLA_WIDTH, D_MODEL), MLA_WIDTH ** -0.5 * DEEPNORM_BETA)
    w_out = nrm(ks[18], (DEPTH, D_MODEL, D_MODEL), D_MODEL ** -0.5 * DEEPNORM_BETA)
    post_ln_g = gain(ks[19], (DEPTH, D_MODEL))
    post_ln_b = nrm(ks[20], (DEPTH, D_MODEL), 0.02)
    return {'x_prompt': x_prompt, 'x_sample': x_sample, 'meta_tokens': meta_tokens,
            'emb_ln_g': emb_ln_g, 'emb_ln_b': emb_ln_b, 'w_in': w_in, 'b_merge': b_merge,
            'w_gla_gate_f': w_gla_gate_f, 'b_gla_gate_f': b_gla_gate_f,
            'w_gla_gate_b': w_gla_gate_b, 'b_gla_gate_b': b_gla_gate_b, 'gla_norm_g': gla_norm_g,
            'w_o_gla': w_o_gla, 'q_a_norm_g': q_a_norm_g, 'w_q_b': w_q_b, 'kv_a_norm_g': kv_a_norm_g,
            'w_kv_b': w_kv_b, 'w_o_mla': w_o_mla, 'w_out': w_out,
            'post_ln_g': post_ln_g, 'post_ln_b': post_ln_b}


def reference(x_prompt, x_sample, meta_tokens, emb_ln_g, emb_ln_b, w_in, b_merge, w_gla_gate_f, b_gla_gate_f,
              w_gla_gate_b, b_gla_gate_b, gla_norm_g, w_o_gla, q_a_norm_g, w_q_b, kv_a_norm_g, w_kv_b,
              w_o_mla, w_out, post_ln_g, post_ln_b):
    layer_params = (w_in, b_merge, w_gla_gate_f, b_gla_gate_f, w_gla_gate_b, b_gla_gate_b, gla_norm_g,
                    w_o_gla, q_a_norm_g, w_q_b, kv_a_norm_g, w_kv_b, w_o_mla, w_out, post_ln_g, post_ln_b)
    y_prompt = encode(x_prompt, meta_tokens, emb_ln_g, emb_ln_b, layer_params)
    y_sample = encode(x_sample, meta_tokens, emb_ln_g, emb_ln_b, layer_params)
    return (y_prompt, y_sample)
```

```cpp
#include <hip/hip_runtime.h>
#include <hip/hip_cooperative_groups.h>
#include <cstdio>
#include <cstdint>
namespace cg = cooperative_groups;

typedef unsigned short bf16_t;
typedef short bf16x8 __attribute__((ext_vector_type(8)));
typedef short s16x4 __attribute__((ext_vector_type(4)));
typedef float f32x4 __attribute__((ext_vector_type(4)));
typedef float f32x16 __attribute__((ext_vector_type(16)));
typedef unsigned u32x4 __attribute__((ext_vector_type(4)));
#define LAS __attribute__((address_space(3)))

#define XB_TMO 128
#define LN_CNT_WORD 3456
constexpr int DM = 1024;
constexpr int NPROJ = 6912;
constexpr int C_GQ = 0, C_GK = 512, C_GV = 1024, C_GR = 2048, C_MZ = 3072, C_MA = 4096, C_MB = 5120, C_CQ = 6144, C_CKV = 6528, C_KR = 6784, C_GLF = 6848, C_GLB = 6864;
constexpr int PMAX = 16896, CMAX = 16384;
constexpr int NPOS = 4112;
constexpr size_t LDS_BYTES = 135168;

struct Chunk { int nseq, S, Lp, nPp, crow0; const float* x; };

struct Params {
  const float *x_prompt, *x_sample, *meta, *emb_g, *emb_b, *w_in, *b_merge, *wgf, *bgf, *wgb, *bgb, *gla_g, *w_o_gla, *q_g, *w_q_b, *kv_g, *w_kv_b, *w_o_mla, *w_out, *pln_g, *pln_b;
  float* out; unsigned* bar;
  bf16_t *W1t, *Wqt, *Wkvt, *Wcat, *Woutt;
  float *cosT, *sinT; float2* lnstat; float2* gst;
  bf16_t *hbf0, *hbf1, *proj; float *gF, *gB, *rstdq, *rstdkv; bf16_t *qbuf, *kvbuf; bf16_t *Of, *Ob; bf16_t *Acat, *mix;
};

__device__ __forceinline__ Chunk get_chunk(const Params& p, int c) {
  Chunk k;
  if (c < 2) { k.nseq = 8; k.S = 2048; k.Lp = 2112; k.nPp = 66; k.crow0 = c * 16384; k.x = p.x_prompt + (size_t)c * 16384 * DM; }
  else { k.nseq = 4; k.S = 4096; k.Lp = 4160; k.nPp = 65; k.crow0 = 32768; k.x = p.x_sample; }
  return k;
}


typedef const __attribute__((address_space(4))) Params* PP;
__device__ __forceinline__ Params load_params() {
  unsigned long v = (unsigned long)__builtin_amdgcn_kernarg_segment_ptr();
  asm volatile("" : "+s"(v));
  Params p; __builtin_memcpy(&p, (PP)v, sizeof(Params)); return p;
}

#define WIDX_LDS_OFF (131072 + 64)
__device__ __forceinline__ int hw_slot() { return (int)__builtin_amdgcn_s_getreg((5 << 11) | 4) & 63; }
__device__ __forceinline__ int tid_fresh() {
  extern __shared__ __attribute__((aligned(16))) char shm_tid[];
  const int key = hw_slot();
  int w = *(volatile LAS int*)((LAS char*)shm_tid + WIDX_LDS_OFF + key * 4);
  w = __builtin_amdgcn_readfirstlane(w);
  unsigned z = 0u; asm volatile("" : "+v"(z));
  int t = w * 64 + (int)__builtin_amdgcn_mbcnt_hi(~0u, __builtin_amdgcn_mbcnt_lo(~0u, z));
  asm volatile("" : "+v"(t)); return t;
}
__device__ __forceinline__ unsigned cvt_pk_bf16(float lo, float hi) { unsigned r; asm volatile("v_cvt_pk_bf16_f32 %0, %1, %2" : "=v"(r) : "v"(lo), "v"(hi)); return r; }
__device__ __forceinline__ bf16_t f2bf(float f) { return (bf16_t)(cvt_pk_bf16(f, 0.f) & 0xffffu); }
__device__ __forceinline__ float bflo(unsigned u) { return __uint_as_float(u << 16); }
__device__ __forceinline__ float bfhi(unsigned u) { return __uint_as_float(u & 0xffff0000u); }
__device__ __forceinline__ float bf2f(bf16_t b) { return __uint_as_float(((unsigned)b) << 16); }
__device__ __forceinline__ float shfl_xor_l(float v, int mask, int lane) { return __int_as_float(__builtin_amdgcn_ds_bpermute((lane ^ mask) << 2, __float_as_int(v))); }
__device__ __forceinline__ float wave_sum(float v, int lane) {
#pragma unroll
  for (int o = 32; o > 0; o >>= 1) v += shfl_xor_l(v, o, lane);
  return v;
}
__device__ __forceinline__ float opaque_f(float c) { asm volatile("" : "+s"(c)); return c; }
__device__ __forceinline__ float sigmoidf_(float x) { return __builtin_amdgcn_rcpf(1.f + __expf(-x)); }
__device__ __forceinline__ float siluf_(float x) { return x * __builtin_amdgcn_rcpf(1.f + __expf(-x)); }
__device__ __forceinline__ float dpp_xor1(float v) { return __int_as_float(__builtin_amdgcn_update_dpp(0, __float_as_int(v), 0xB1, 0xf, 0xf, false)); }
__device__ __forceinline__ float dpp_xor2(float v) { return __int_as_float(__builtin_amdgcn_update_dpp(0, __float_as_int(v), 0x4E, 0xf, 0xf, false)); }
__device__ __forceinline__ float dpp_hmirror(float v) { return __int_as_float(__builtin_amdgcn_update_dpp(0, __float_as_int(v), 0x141, 0xf, 0xf, false)); }
__device__ __forceinline__ float dpp_mirror(float v) { return __int_as_float(__builtin_amdgcn_update_dpp(0, __float_as_int(v), 0x140, 0xf, 0xf, false)); }

namespace pg8 {
constexpr int BM = 256, BK = 64, HALF = 128, HTB = HALF * BK * 2, STAGE_BYTES = 8 * HTB, NXCD = 8, WGM = 8;
__device__ __forceinline__ int lds_byte(int r, int c) { const int st = (r >> 4) * 2 + (c >> 5), rr = r & 15, cc = c & 31, ob = rr * 64 + cc * 2; return st * 1024 + (ob ^ (((ob >> 9) & 1) << 5)); }
__device__ __forceinline__ void stage_rc(int b, int& R, int& C) { const int st = b / 1024, sb = b % 1024, swz = sb ^ (((sb >> 9) & 1) << 5); R = (st >> 1) * 16 + swz / 64; C = (st & 1) * 32 + (swz % 64) / 2; }
__device__ __forceinline__ int perm32(int rho) { const int n = rho >> 4, i = rho & 15; return 8 * (i >> 2) + 4 * n + (i & 3); }

struct Unit { int pm, pn; };
struct Gemm { const bf16_t* A; const bf16_t* Bt; int lda, ldb, K, nM, nN, mapS, mapLp; };

struct StaticOrder {
  int nM, nN, nwg, G, c;
  __device__ void init(int nM_, int nN_, int G_, int c_) { nM = nM_; nN = nN_; nwg = nM * nN; G = G_; c = c_; }
  __device__ bool next(int i, Unit& u) const {
    const long L = (long)i * G + c; if (L >= nwg) return false;
    int wgid = (int)L; { const int q = nwg / NXCD, r = nwg % NXCD, xcd = wgid % NXCD, off = wgid / NXCD; wgid = (xcd < r ? xcd * (q + 1) : r * (q + 1) + (xcd - r) * q) + off; }
    const int nig = WGM * nN, gid = wgid / nig, fm = gid * WGM, gsz = (nM - fm) < WGM ? (nM - fm) : WGM;
    u.pm = fm + ((wgid % nig) % gsz); u.pn = (wgid % nig) / gsz; return true;
  }
};
__device__ __forceinline__ size_t arow(const Gemm& g, int pm) {
  if (g.mapS == 0) return (size_t)pm * BM;
  const int rc = pm * BM; return (size_t)(rc / g.mapS) * g.mapLp + 64 + (rc % g.mapS);
}

template <class Epi>
__device__ __forceinline__ void gemm_phase(LAS unsigned char* lds, const Gemm g, const StaticOrder& S, const Epi& E) {
  const int tid = tid_fresh(), wid = __builtin_amdgcn_readfirstlane(tid >> 6), lane = tid & 63, wr = wid >> 2, wc = wid & 3, fr = lane & 15, fq = lane >> 4;
  const int K = g.K, nt = K / BK;
  unsigned voffA[2], voffB[2];
#pragma unroll
  for (int i = 0; i < 2; ++i) { int R, C; stage_rc(tid * 16 + i * 8192, R, C); const int Rb = Epi::PERM ? ((R & ~31) + perm32(R & 31)) : R;
    voffA[i] = (unsigned)(R * g.lda + C) * 2u; voffB[i] = (unsigned)(Rb * g.ldb + C) * 2u; }
  const size_t kstep = (size_t)(BK * 2);
  const size_t hstepA = (size_t)HALF * g.lda * 2, hstepB = (size_t)HALF * g.ldb * 2;
  const unsigned ldsw = (unsigned)wid * 1024u;
  const int aoff = lds_byte(wr * 64 + fr, fq * 8), boff = lds_byte(wc * 32 + fr, fq * 8);
#define PG8_SA(b, h) (((b) * 2 + (h)) * HTB)
#define PG8_SB(b, h) ((4 + (b) * 2 + (h)) * HTB)
#define PG8_STAGE(bufoff, gbase, voff) do { _Pragma("unroll") for (int _i = 0; _i < 2; ++_i) \
    __builtin_amdgcn_global_load_lds((const unsigned*)((const char*)(gbase) + (voff)[_i]), (LAS unsigned*)(lds + (bufoff) + ldsw + _i * 8192), 16, 0, 0); } while (0)
#define PG8_LDA(dst, b, h) do { _Pragma("unroll") for (int m = 0; m < 4; ++m) _Pragma("unroll") for (int k = 0; k < 2; ++k) dst[m][k] = *(const LAS bf16x8*)(lds + PG8_SA(b, h) + aoff + m * 2048 + k * 1024); } while (0)
#define PG8_LDB(dst, b, h) do { _Pragma("unroll") for (int n = 0; n < 2; ++n) _Pragma("unroll") for (int k = 0; k < 2; ++k) dst[n][k] = *(const LAS bf16x8*)(lds + PG8_SB(b, h) + boff + n * 2048 + k * 1024); } while (0)
#define PG8_MMA(ai, bj, At, Bt) do { __builtin_amdgcn_s_setprio(1); _Pragma("unroll") for (int m = 0; m < 4; ++m) _Pragma("unroll") for (int n = 0; n < 2; ++n) _Pragma("unroll") for (int k = 0; k < 2; ++k) \
    acc[ai][bj][m][n] = __builtin_amdgcn_mfma_f32_16x16x32_bf16(Bt[n][k], At[m][k], acc[ai][bj][m][n], 0, 0, 0); __builtin_amdgcn_s_setprio(0); } while (0)
#define PG8_WAIT_V(n) asm volatile("s_waitcnt vmcnt(" #n ")" ::: "memory")
#define PG8_WAIT_L(n) asm volatile("s_waitcnt lgkmcnt(" #n ")" ::: "memory")
#define PG8_BAR __builtin_amdgcn_s_barrier()
#define PG8_SCHED __builtin_amdgcn_sched_barrier(0)
  Unit cur, nxt; int ui = 0;
  if (!S.next(0, cur)) return;
  f32x4 acc[2][2][4][2];
#pragma unroll
  for (int a = 0; a < 2; ++a)
#pragma unroll
    for (int b = 0; b < 2; ++b)
#pragma unroll
      for (int m = 0; m < 4; ++m)
#pragma unroll
        for (int n = 0; n < 2; ++n) acc[a][b][m][n] = (f32x4){0.f, 0.f, 0.f, 0.f};
  bf16x8 At[4][2], B0[2][2], B1[2][2];
  const char* cA = (const char*)g.A + arow(g, cur.pm) * g.lda * 2; const char* cB = (const char*)g.Bt + (size_t)cur.pn * BM * g.ldb * 2;
  PG8_STAGE(PG8_SB(0, 0), cB, voffB); PG8_STAGE(PG8_SA(0, 0), cA, voffA); PG8_STAGE(PG8_SB(0, 1), cB + hstepB, voffB); PG8_STAGE(PG8_SA(0, 1), cA + hstepA, voffA);
  if (wr == 1) PG8_BAR;
  PG8_WAIT_V(4); PG8_BAR;
  PG8_STAGE(PG8_SB(1, 0), cB + kstep, voffB); PG8_STAGE(PG8_SA(1, 0), cA + kstep, voffA); PG8_STAGE(PG8_SB(1, 1), cB + hstepB + kstep, voffB);
  PG8_WAIT_V(6); PG8_BAR;
  for (;;) {
    const bool has_next = S.next(ui + 1, nxt);
    const char* nA = has_next ? (const char*)g.A + arow(g, nxt.pm) * g.lda * 2 : cA; const char* nB = has_next ? (const char*)g.Bt + (size_t)nxt.pn * BM * g.ldb * 2 : cB;
#pragma unroll 1
    for (int t = 0; t < nt; t += 2) {
      if constexpr (Epi::DUAL) { if (t == (nt >> 1)) E.mid(acc, cur, wr, wc, fr, fq); }
      const bool last = (t == nt - 2);
      const char* a1 = cA + (size_t)(t + 1) * kstep;
      const char* a2 = last ? nA : cA + (size_t)(t + 2) * kstep; const char* b2 = last ? nB : cB + (size_t)(t + 2) * kstep;
      const char* a3 = a2 + kstep; const char* b3 = b2 + kstep;
      PG8_LDB(B0, 0, 0); PG8_SCHED; PG8_LDA(At, 0, 0); PG8_STAGE(PG8_SA(1, 1), a1 + hstepA, voffA);
      PG8_WAIT_L(8); PG8_BAR; PG8_WAIT_L(0); PG8_MMA(0, 0, At, B0); PG8_BAR; PG8_SCHED;
      PG8_LDB(B1, 0, 1); PG8_STAGE(PG8_SB(0, 0), b2, voffB);
      PG8_BAR; PG8_WAIT_L(0); PG8_MMA(0, 1, At, B1); PG8_BAR;
      PG8_LDA(At, 0, 1); PG8_STAGE(PG8_SA(0, 0), a2, voffA);
      PG8_BAR; PG8_WAIT_L(0); PG8_MMA(1, 0, At, B0); PG8_BAR; PG8_SCHED;
      PG8_STAGE(PG8_SB(0, 1), b2 + hstepB, voffB);
      PG8_WAIT_V(6); PG8_BAR; PG8_MMA(1, 1, At, B1); PG8_BAR;
      PG8_LDB(B0, 1, 0); PG8_SCHED; PG8_LDA(At, 1, 0); PG8_STAGE(PG8_SA(0, 1), a2 + hstepA, voffA);
      PG8_WAIT_L(8); PG8_BAR; PG8_WAIT_L(0); PG8_MMA(0, 0, At, B0); PG8_BAR; PG8_SCHED;
      PG8_LDB(B1, 1, 1); PG8_STAGE(PG8_SB(1, 0), b3, voffB);
      PG8_BAR; PG8_WAIT_L(0); PG8_MMA(0, 1, At, B1); PG8_BAR;
      PG8_LDA(At, 1, 1); PG8_STAGE(PG8_SA(1, 0), a3, voffA);
      PG8_BAR; PG8_WAIT_L(0); PG8_MMA(1, 0, At, B0); PG8_BAR; PG8_SCHED;
      PG8_STAGE(PG8_SB(1, 1), b3 + hstepB, voffB);
      PG8_WAIT_V(6); PG8_BAR; PG8_MMA(1, 1, At, B1); PG8_BAR;
    }
    if constexpr (!Epi::AFTER_DRAIN) E(acc, cur, wr, wc, fr, fq);
    if (!has_next) break;
#pragma unroll
    for (int a = 0; a < 2; ++a)
#pragma unroll
      for (int b = 0; b < 2; ++b)
#pragma unroll
        for (int m = 0; m < 4; ++m)
#pragma unroll
          for (int n = 0; n < 2; ++n) acc[a][b][m][n] = (f32x4){0.f, 0.f, 0.f, 0.f};
    cur = nxt; cA = nA; cB = nB; ++ui;
  }
  PG8_WAIT_V(0);
  if (wr == 0) PG8_BAR;
  PG8_BAR;
  if constexpr (Epi::AFTER_DRAIN) E.fused(acc, cur, wr, wc, fr, fq, (char*)lds);
#undef PG8_SA
#undef PG8_SB
#undef PG8_STAGE
#undef PG8_LDA
#undef PG8_LDB
#undef PG8_MMA
#undef PG8_WAIT_V
#undef PG8_WAIT_L
#undef PG8_BAR
#undef PG8_SCHED
}
}
using pg8::Unit;

__device__ __forceinline__ u32x4 pack8(f32x4 a, f32x4 b) { return (u32x4){cvt_pk_bf16(a[0], a[1]), cvt_pk_bf16(a[2], a[3]), cvt_pk_bf16(b[0], b[1]), cvt_pk_bf16(b[2], b[3])}; }
__device__ __forceinline__ void rope8(f32x4& a, f32x4& b, const float* cosT, const float* sinT, int pos, int i0) {
  const f32x4 c = *(const f32x4*)(cosT + pos * 32 + i0), s = *(const f32x4*)(sinT + pos * 32 + i0);
  f32x4 oa, ob;
  oa[0] = a[0] * c[0] - a[1] * s[0]; oa[1] = a[0] * s[0] + a[1] * c[0];
  oa[2] = a[2] * c[1] - a[3] * s[1]; oa[3] = a[2] * s[1] + a[3] * c[1];
  ob[0] = b[0] * c[2] - b[1] * s[2]; ob[1] = b[0] * s[2] + b[1] * c[2];
  ob[2] = b[2] * c[3] - b[3] * s[3]; ob[3] = b[2] * s[3] + b[3] * c[3];
  a = oa; b = ob;
}

struct Epi1 {
  static constexpr bool PERM = true, AFTER_DRAIN = false, DUAL = false;
  bf16_t* proj; const float* cosT; const float* sinT; int Lp;
  __device__ __forceinline__ void operator()(const f32x4 (&acc)[2][2][4][2], const Unit& u, int wr, int wc, int fr, int fq) const {
    const int row0 = u.pm * 256 + wr * 64 + fr, colt = u.pn * 256 + wc * 32 + 8 * fq;
#pragma unroll
    for (int ai = 0; ai < 2; ++ai)
#pragma unroll
      for (int m = 0; m < 4; ++m) {
        const int row = row0 + ai * 128 + m * 16;
        bf16_t* rowp = proj + (size_t)row * NPROJ;
#pragma unroll
        for (int bj = 0; bj < 2; ++bj) {
          const int col0 = colt + bj * 128;
          f32x4 v0 = acc[ai][bj][m][0], v1 = acc[ai][bj][m][1];
          if (u.pn == 26 && col0 >= C_KR && col0 < C_KR + 64) {
            int t = row % Lp - 48; if (t < 0) t = 0;
            rope8(v0, v1, cosT, sinT, t, (col0 - C_KR) >> 1);
          }
          *(u32x4*)(rowp + col0) = pack8(v0, v1);
        }
      }
  }
};
struct Epi2 {
  static constexpr bool PERM = true, AFTER_DRAIN = false, DUAL = false;
  bf16_t* q; const float* rstdq; const float* cosT; const float* sinT; int S, Lp;
  __device__ __forceinline__ void operator()(const f32x4 (&acc)[2][2][4][2], const Unit& u, int wr, int wc, int fr, int fq) const {
    const int row0 = u.pm * 256 + wr * 64 + fr, colt = u.pn * 256 + wc * 32 + 8 * fq;
    float rsv[8]; int posv[8];
#pragma unroll
    for (int i = 0; i < 8; ++i) { const int row = row0 + (i >> 2) * 128 + (i & 3) * 16; const int s = row % S; posv[i] = 16 + s; rsv[i] = rstdq[(row / S) * Lp + 64 + s]; }
#pragma unroll
    for (int bj = 0; bj < 2; ++bj) {
      const int col0 = colt + bj * 128, j = col0 % 192;
      if (j >= 128) {
        const int i0 = (j - 128) >> 1;
        f32x4 cv[8], sv[8];
#pragma unroll
        for (int i = 0; i < 8; ++i) { cv[i] = *(const f32x4*)(cosT + posv[i] * 32 + i0); sv[i] = *(const f32x4*)(sinT + posv[i] * 32 + i0); }
#pragma unroll
        for (int i = 0; i < 8; ++i) { const int ai = i >> 2, m = i & 3, row = row0 + ai * 128 + m * 16;
          const f32x4 a = acc[ai][bj][m][0] * rsv[i], b = acc[ai][bj][m][1] * rsv[i]; const f32x4 c = cv[i], sn = sv[i];
          f32x4 oa, ob;
          oa[0] = a[0] * c[0] - a[1] * sn[0]; oa[1] = a[0] * sn[0] + a[1] * c[0]; oa[2] = a[2] * c[1] - a[3] * sn[1]; oa[3] = a[2] * sn[1] + a[3] * c[1];
          ob[0] = b[0] * c[2] - b[1] * sn[2]; ob[1] = b[0] * sn[2] + b[1] * c[2]; ob[2] = b[2] * c[3] - b[3] * sn[3]; ob[3] = b[2] * sn[3] + b[3] * c[3];
          *(u32x4*)(q + (size_t)row * 1536 + col0) = pack8(oa, ob); }
      } else {
#pragma unroll
        for (int i = 0; i < 8; ++i) { const int ai = i >> 2, m = i & 3, row = row0 + ai * 128 + m * 16;
          *(u32x4*)(q + (size_t)row * 1536 + col0) = pack8(acc[ai][bj][m][0] * rsv[i], acc[ai][bj][m][1] * rsv[i]); }
      }
    }
  }
};
struct Epi3 {
  static constexpr bool PERM = true, AFTER_DRAIN = false, DUAL = false;
  bf16_t* kv; const float* rstdkv;
  __device__ __forceinline__ void operator()(const f32x4 (&acc)[2][2][4][2], const Unit& u, int wr, int wc, int fr, int fq) const {
    const int row0 = u.pm * 256 + wr * 64 + fr, colt = u.pn * 256 + wc * 32 + 8 * fq;
    float rsv[8];
#pragma unroll
    for (int i = 0; i < 8; ++i) rsv[i] = rstdkv[row0 + (i >> 2) * 128 + (i & 3) * 16];
#pragma unroll
    for (int ai = 0; ai < 2; ++ai)
#pragma unroll
      for (int m = 0; m < 4; ++m) {
        const int row = row0 + ai * 128 + m * 16;
        const float rs = rsv[ai * 4 + m];
        bf16_t* rowp = kv + (size_t)row * 2048;
#pragma unroll
        for (int bj = 0; bj < 2; ++bj) {
          const int col0 = colt + bj * 128;
          *(u32x4*)(rowp + col0) = pack8(acc[ai][bj][m][0] * rs, acc[ai][bj][m][1] * rs);
        }
      }
  }
};
template <int SECOND> struct Epi45 {
  static constexpr bool PERM = true, AFTER_DRAIN = false, DUAL = false;
  bf16_t* mix; const bf16_t* proj; const float* bm; int S, Lp;
  __device__ __forceinline__ void operator()(const f32x4 (&acc)[2][2][4][2], const Unit& u, int wr, int wc, int fr, int fq) const {
    const int row0 = u.pm * 256 + wr * 64 + fr, colt = u.pn * 256 + wc * 32 + 8 * fq;
#pragma unroll
    for (int ai = 0; ai < 2; ++ai)
#pragma unroll
      for (int m = 0; m < 4; ++m) {
        const int row = row0 + ai * 128 + m * 16;
        const int s = row % S, prow = (row / S) * Lp + 64 + s;
        const bf16_t* gp = proj + (size_t)prow * NPROJ + (SECOND ? C_MB : C_MA);
        bf16_t* rowp = mix + (size_t)row * 1024;
#pragma unroll
        for (int bj = 0; bj < 2; ++bj) {
          const int col0 = colt + bj * 128;
          const u32x4 gv = *(const u32x4*)(gp + col0);
          const f32x4 b0 = *(const f32x4*)(bm + SECOND * 1024 + col0), b1 = *(const f32x4*)(bm + SECOND * 1024 + col0 + 4);
          f32x4 g0, g1;
          g0[0] = sigmoidf_(bflo(gv[0]) + b0[0]); g0[1] = sigmoidf_(bfhi(gv[0]) + b0[1]); g0[2] = sigmoidf_(bflo(gv[1]) + b0[2]); g0[3] = sigmoidf_(bfhi(gv[1]) + b0[3]);
          g1[0] = sigmoidf_(bflo(gv[2]) + b1[0]); g1[1] = sigmoidf_(bfhi(gv[2]) + b1[1]); g1[2] = sigmoidf_(bflo(gv[3]) + b1[2]); g1[3] = sigmoidf_(bfhi(gv[3]) + b1[3]);
          f32x4 v0 = acc[ai][bj][m][0] * g0, v1 = acc[ai][bj][m][1] * g1;
          if (SECOND) {
            const u32x4 old = *(const u32x4*)(rowp + col0);
            v0[0] += bflo(old[0]); v0[1] += bfhi(old[0]); v0[2] += bflo(old[1]); v0[3] += bfhi(old[1]);
            v1[0] += bflo(old[2]); v1[1] += bfhi(old[2]); v1[2] += bflo(old[3]); v1[3] += bfhi(old[3]);
          }
          *(u32x4*)(rowp + col0) = pack8(v0, v1);
        }
      }
  }
};
struct Epi45D {
  static constexpr bool PERM = true, AFTER_DRAIN = false, DUAL = true;
  bf16_t* mix; const bf16_t* proj; const float* bm; int S, Lp;
  template <int FINAL>
  __device__ __forceinline__ void run(f32x4 (&acc)[2][2][4][2], const Unit& u, int wr, int wc, int fr, int fq) const {
    const int row0 = u.pm * 256 + wr * 64 + fr, colt = u.pn * 256 + wc * 32 + 8 * fq;
#pragma unroll
    for (int ai = 0; ai < 2; ++ai) {
      const bf16_t* gp[4];
#pragma unroll
      for (int m = 0; m < 4; ++m) { const int row = row0 + ai * 128 + m * 16; const int s = row % S, prow = (row / S) * Lp + 64 + s; gp[m] = proj + (size_t)prow * NPROJ + colt; }
#pragma unroll
      for (int bj = 0; bj < 2; ++bj) {
        const int col0 = colt + bj * 128;
        u32x4 yv[4], xv[4];
#pragma unroll
        for (int m = 0; m < 4; ++m) { yv[m] = *(const u32x4*)(gp[m] + C_MB + bj * 128); if (!FINAL) xv[m] = *(const u32x4*)(gp[m] + C_MA + bj * 128); }
        const f32x4 c0 = *(const f32x4*)(bm + 1024 + col0), c1 = *(const f32x4*)(bm + 1024 + col0 + 4);
        f32x4 b0 = {}, b1 = {};
        if (!FINAL) { b0 = *(const f32x4*)(bm + col0); b1 = *(const f32x4*)(bm + col0 + 4); }
#pragma unroll
        for (int m = 0; m < 4; ++m) {
          float ey[8];
          ey[0] = 1.f + __expf(-(bflo(yv[m][0]) + c0[0])); ey[1] = 1.f + __expf(-(bfhi(yv[m][0]) + c0[1])); ey[2] = 1.f + __expf(-(bflo(yv[m][1]) + c0[2])); ey[3] = 1.f + __expf(-(bfhi(yv[m][1]) + c0[3]));
          ey[4] = 1.f + __expf(-(bflo(yv[m][2]) + c1[0])); ey[5] = 1.f + __expf(-(bfhi(yv[m][2]) + c1[1])); ey[6] = 1.f + __expf(-(bflo(yv[m][3]) + c1[2])); ey[7] = 1.f + __expf(-(bfhi(yv[m][3]) + c1[3]));
          if (FINAL) {
            f32x4 v0 = acc[ai][bj][m][0], v1 = acc[ai][bj][m][1];
#pragma unroll
            for (int e = 0; e < 4; ++e) { v0[e] *= __builtin_amdgcn_rcpf(ey[e]); v1[e] *= __builtin_amdgcn_rcpf(ey[4 + e]); }
            const int row = row0 + ai * 128 + m * 16;
            *(u32x4*)(mix + (size_t)row * 1024 + col0) = pack8(v0, v1);
          } else {
            float sx[8];
            sx[0] = sigmoidf_(bflo(xv[m][0]) + b0[0]); sx[1] = sigmoidf_(bfhi(xv[m][0]) + b0[1]); sx[2] = sigmoidf_(bflo(xv[m][1]) + b0[2]); sx[3] = sigmoidf_(bfhi(xv[m][1]) + b0[3]);
            sx[4] = sigmoidf_(bflo(xv[m][2]) + b1[0]); sx[5] = sigmoidf_(bfhi(xv[m][2]) + b1[1]); sx[6] = sigmoidf_(bflo(xv[m][3]) + b1[2]); sx[7] = sigmoidf_(bfhi(xv[m][3]) + b1[3]);
#pragma unroll
            for (int e = 0; e < 4; ++e) { acc[ai][bj][m][0][e] *= sx[e] * ey[e]; acc[ai][bj][m][1][e] *= sx[4 + e] * ey[4 + e]; }
          }
        }
      }
    }
  }
  __device__ __forceinline__ void mid(f32x4 (&acc)[2][2][4][2], const Unit& u, int wr, int wc, int fr, int fq) const {
    asm volatile("" : "+v"(fr), "+v"(fq));
    run<0>(acc, u, wr, wc, fr, fq); }
  __device__ __forceinline__ void operator()(f32x4 (&acc)[2][2][4][2], const Unit& u, int wr, int wc, int fr, int fq) const { run<1>(acc, u, wr, wc, fr, fq); }
};
struct Epi6 {
  static constexpr bool PERM = true, AFTER_DRAIN = false, DUAL = false;
  float* out; const float* x; const float2* lnstat; const float* eg; const float* eb;
  __device__ __forceinline__ void operator()(const f32x4 (&acc)[2][2][4][2], const Unit& u, int wr, int wc, int fr, int fq) const {
    const int row0 = u.pm * 256 + wr * 64 + fr, colt = u.pn * 256 + wc * 32 + 8 * fq;
    const float ALPHA = 1.189207115002721f;
#pragma unroll
    for (int ai = 0; ai < 2; ++ai)
#pragma unroll
      for (int m = 0; m < 4; ++m) {
        const int row = row0 + ai * 128 + m * 16;
        const float2 st = lnstat[row];
        const float* xr = x + (size_t)row * 1024; float* orow = out + (size_t)row * 1024;
#pragma unroll
        for (int bj = 0; bj < 2; ++bj) {
          const int col0 = colt + bj * 128;
#pragma unroll
          for (int n = 0; n < 2; ++n) {
            const f32x4 xv = *(const f32x4*)(xr + col0 + 4 * n), gv = *(const f32x4*)(eg + col0 + 4 * n), bv = *(const f32x4*)(eb + col0 + 4 * n);
            f32x4 h = (xv - st.x) * st.y * gv + bv;
            *(f32x4*)(orow + col0 + 4 * n) = ALPHA * h + acc[ai][bj][m][n];
          }
        }
      }
  }
};

struct Epi6Ln {
  static constexpr bool PERM = true, AFTER_DRAIN = true, DUAL = false;
  int cc;
  __device__ __forceinline__ void fused(f32x4 (&acc)[2][2][4][2], const Unit& u, int wr, int wc, int fr, int fq, char* lds) const {
    const Params p = load_params(); const Chunk ck = get_chunk(p, cc);
    float* out = p.out + (size_t)ck.crow0 * DM; const float* x = ck.x; const float2* lnstat = p.lnstat + ck.crow0;
    const float* eg = p.emb_g; const float* eb = p.emb_b; const float* pg = p.pln_g; const float* pb = p.pln_b;
    float2* gst = p.gst + (size_t)cc * 64 * 4 * 256; unsigned* cnt = p.bar + LN_CNT_WORD + cc * 64; unsigned* tmo = p.bar + XB_TMO;
    float* red = (float*)lds; float* rst = red + 2048;
    const int tid = tid_fresh(), colt = u.pn * 256 + wc * 32 + 8 * fq;
    const float ALPHA = 1.189207115002721f;
    f32x4 gvv[4], bvv[4];
#pragma unroll
    for (int j = 0; j < 4; ++j) { const int col = colt + (j >> 1) * 128 + 4 * (j & 1); gvv[j] = *(const f32x4*)(eg + col); bvv[j] = *(const f32x4*)(eb + col); }
#pragma unroll
    for (int ai = 0; ai < 2; ++ai) {
      f32x4 xv[4][4]; float2 st[4];
#pragma unroll
      for (int m = 0; m < 4; ++m) { const int row = u.pm * 256 + wr * 64 + ai * 128 + m * 16 + fr; st[m] = lnstat[row]; const float* xr = x + (size_t)row * 1024;
#pragma unroll
        for (int j = 0; j < 4; ++j) xv[m][j] = *(const f32x4*)(xr + colt + (j >> 1) * 128 + 4 * (j & 1)); }
#pragma unroll
      for (int m = 0; m < 4; ++m) {
        const int lrow = wr * 64 + ai * 128 + m * 16 + fr;
        float s1 = 0.f, s2 = 0.f;
#pragma unroll
        for (int j = 0; j < 4; ++j) { const int bj = j >> 1, n = j & 1;
          const f32x4 z = ALPHA * ((xv[m][j] - st[m].x) * st[m].y * gvv[j] + bvv[j]) + acc[ai][bj][m][n];
          acc[ai][bj][m][n] = z; s1 += z[0] + z[1] + z[2] + z[3]; s2 += z[0] * z[0] + z[1] * z[1] + z[2] * z[2] + z[3] * z[3]; }
        s1 += shfl_xor_l(s1, 16, tid & 63); s1 += shfl_xor_l(s1, 32, tid & 63); s2 += shfl_xor_l(s2, 16, tid & 63); s2 += shfl_xor_l(s2, 32, tid & 63);
        if (fq == 0) { red[(lrow * 4 + wc) * 2] = s1; red[(lrow * 4 + wc) * 2 + 1] = s2; }
      }
    }
    __syncthreads();
    if (tid < 256) { float a = 0.f, b = 0.f;
#pragma unroll
      for (int w = 0; w < 4; ++w) { a += red[(tid * 4 + w) * 2]; b += red[(tid * 4 + w) * 2 + 1]; }
      const unsigned long long rec = (unsigned long long)__float_as_uint(a) | ((unsigned long long)__float_as_uint(b) << 32);
      __hip_atomic_store((unsigned long long*)(gst + (size_t)(u.pm * 4 + u.pn) * 256 + tid), rec, __ATOMIC_RELAXED, __HIP_MEMORY_SCOPE_AGENT); }
    asm volatile("s_waitcnt vmcnt(0)" ::: "memory"); __syncthreads();
    if (tid == 0) {
      __hip_atomic_fetch_add(cnt + u.pm, 1u, __ATOMIC_RELAXED, __HIP_MEMORY_SCOPE_AGENT);
      unsigned sp = 0;
      while (__hip_atomic_load(cnt + u.pm, __ATOMIC_RELAXED, __HIP_MEMORY_SCOPE_AGENT) < 4u) { __builtin_amdgcn_s_sleep(1);
        if ((++sp & 255u) == 0u) { if (__hip_atomic_load(tmo, __ATOMIC_RELAXED, __HIP_MEMORY_SCOPE_AGENT)) break; if (sp > (1u << 20)) { atomicAdd(tmo, 1u); break; } } }
    }
    __syncthreads();
    if (tid < 256) { float a = 0.f, b = 0.f;
#pragma unroll
      for (int t = 0; t < 4; ++t) { const unsigned long long rec = __hip_atomic_load((unsigned long long*)(gst + (size_t)(u.pm * 4 + t) * 256 + tid), __ATOMIC_RELAXED, __HIP_MEMORY_SCOPE_AGENT);
        a += __uint_as_float((unsigned)rec); b += __uint_as_float((unsigned)(rec >> 32)); }
      const float mean = a * (1.f / 1024.f), var = fmaxf(b * (1.f / 1024.f) - mean * mean, 0.f);
      rst[tid * 2] = mean; rst[tid * 2 + 1] = rsqrtf(var + opaque_f(1e-5f)); }
    __syncthreads();
#pragma unroll
    for (int ai = 0; ai < 2; ++ai)
#pragma unroll
      for (int m = 0; m < 4; ++m) {
        const int lrow = wr * 64 + ai * 128 + m * 16 + fr, row = u.pm * 256 + lrow;
        const float mean = rst[lrow * 2], rstd = rst[lrow * 2 + 1]; float* orow = out + (size_t)row * 1024;
#pragma unroll
        for (int bj = 0; bj < 2; ++bj)
#pragma unroll
          for (int n = 0; n < 2; ++n) { const int col = colt + bj * 128 + 4 * n;
            *(f32x4*)(orow + col) = (acc[ai][bj][m][n] - mean) * rstd * *(const f32x4*)(pg + col) + *(const f32x4*)(pb + col); }
      }
    __syncthreads();
  }
};

namespace att {
constexpr int KVBLK = 64;
constexpr float SCALE = 0.07216878364870322f;
constexpr float THR = 8.f;
constexpr int SHM_V = 64 * 128 * 2, SHM_K = 64 * 128 * 2, SHM_R = 64 * 64 * 2;
constexpr int OFF_K = 2 * SHM_V, OFF_R = OFF_K + 2 * SHM_K, OFF_WS = OFF_R + 2 * SHM_R;
constexpr int LDQ = 1536, LDKV = 2048, LDP = NPROJ, LDO = 2048;
#define KSWZ(row, colB) ((row) * 256 + ((colB) ^ (((row) & 7) << 4)))
#define RSWZ(row, colB) ((row) * 128 + ((colB) ^ (((row) & 7) << 4)))
#define SBAR() __builtin_amdgcn_sched_barrier(0)
__device__ __forceinline__ int crow(int r, int hi) { return (r & 3) + 8 * (r >> 2) + 4 * hi; }

__device__ __forceinline__ void partialSM(f32x16& p0, f32x16& p1, float& m_reg, float& mn, float& alpha) {
  const float C = opaque_f(SCALE * 1.4426950408889634f);
  float pmax = p0[0];
#pragma unroll
  for (int r = 1; r < 16; ++r) pmax = fmaxf(pmax, p0[r]);
#pragma unroll
  for (int r = 0; r < 16; ++r) pmax = fmaxf(pmax, p1[r]);
  { auto rr = __builtin_amdgcn_permlane32_swap(__float_as_uint(pmax), __float_as_uint(pmax), false, false);
    pmax = fmaxf(__uint_as_float(rr[0]), __uint_as_float(rr[1])); }
  if (__builtin_expect(__all(pmax - m_reg <= THR / SCALE), 1)) { mn = m_reg; alpha = 1.f; }
  else { mn = fmaxf(m_reg, pmax); alpha = __builtin_amdgcn_exp2f((m_reg - mn) * C); m_reg = mn; }
  float mnC = -mn * C;
#pragma unroll
  for (int r = 0; r < 16; ++r) p0[r] = fmaf(p0[r], C, mnC);
#pragma unroll
  for (int r = 0; r < 16; ++r) p1[r] = fmaf(p1[r], C, mnC);
#pragma unroll
  for (int r = 0; r < 16; ++r) p0[r] = __builtin_amdgcn_exp2f(p0[r]);
}
__device__ __forceinline__ void finishSM(f32x16& p0, f32x16& p1, float alpha, float& l_reg, bf16x8& pa0, bf16x8& pa1, bf16x8& pa2, bf16x8& pa3) {
#pragma unroll
  for (int r = 0; r < 16; ++r) p1[r] = __builtin_amdgcn_exp2f(p1[r]);
  float ps = 0;
#pragma unroll
  for (int r = 0; r < 16; ++r) ps += p0[r];
#pragma unroll
  for (int r = 0; r < 16; ++r) ps += p1[r];
  { auto rr = __builtin_amdgcn_permlane32_swap(__float_as_uint(ps), __float_as_uint(ps), false, false);
    ps = __uint_as_float(rr[0]) + __uint_as_float(rr[1]); }
  l_reg = l_reg * alpha + ps;
#define PK4(P, BASE, OUT) do { unsigned a0 = cvt_pk_bf16(P[BASE + 0], P[BASE + 1]), a1 = cvt_pk_bf16(P[BASE + 2], P[BASE + 3]);   \
    unsigned b0 = cvt_pk_bf16(P[BASE + 4], P[BASE + 5]), b1 = cvt_pk_bf16(P[BASE + 6], P[BASE + 7]);                              \
    auto r0 = __builtin_amdgcn_permlane32_swap(a0, b0, false, false); auto r1 = __builtin_amdgcn_permlane32_swap(a1, b1, false, false); \
    u32x4 w = {r0[0], r1[0], r0[1], r1[1]}; OUT = *reinterpret_cast<bf16x8*>(&w); } while (0)
  PK4(p0, 0, pa0); PK4(p0, 8, pa1); PK4(p1, 0, pa2); PK4(p1, 8, pa3);
#undef PK4
}
template <int OFF> __device__ __forceinline__ bf16x8 ds128(int addr) {
  bf16x8 r; asm volatile("ds_read_b128 %0, %1 offset:%2" : "=&v"(r) : "v"(addr), "i"(OFF) : "memory"); return r;
}
__device__ __forceinline__ void qkt(f32x16& p0, f32x16& p1, const char* Ks, const char* Rs, const bf16x8* qr, int r32, int hi) {
  p0 = f32x16{}; p1 = f32x16{};
  const int sx = (r32 & 7) << 4, hb = hi * 16;
  const int kb = (int)(uintptr_t)Ks + r32 * 256, rb = (int)(uintptr_t)Rs + r32 * 128;
  bf16x8 b0[12], b1[12];
#define QK_LOAD(d) do { if ((d) < 8) { const int ad = kb + ((((d) * 32) + hb) ^ sx); b0[d] = ds128<0>(ad); b1[d] = ds128<8192>(ad); } \
                        else { const int ad = rb + (((((d) - 8) * 32) + hb) ^ sx); b0[d] = ds128<0>(ad); b1[d] = ds128<4096>(ad); } } while (0)
  QK_LOAD(0); QK_LOAD(1);
#pragma unroll
  for (int d = 0; d < 12; ++d) {
    if (d < 11) asm volatile("s_waitcnt lgkmcnt(2)" ::: "memory"); else asm volatile("s_waitcnt lgkmcnt(0)" ::: "memory");
    __builtin_amdgcn_sched_barrier(0);
    if (d + 2 < 12) QK_LOAD(d + 2);
    p0 = __builtin_amdgcn_mfma_f32_32x32x16_bf16(b0[d], qr[d], p0, 0, 0, 0);
    p1 = __builtin_amdgcn_mfma_f32_32x32x16_bf16(b1[d], qr[d], p1, 0, 0, 0);
  }
#undef QK_LOAD
}
__device__ __forceinline__ int v_st(int k, int c) { const int kk = (k & ~0xC) | ((k & 4) << 1) | ((k & 8) >> 1); return ((kk >> 3) * 4 + (c >> 5)) * 512 + ((kk & 7) * 32 + (c & 31)) * 2; }
__device__ __forceinline__ int v_rd_base(int lane) { return ((lane & 3) << 3) | (((lane >> 2) & 3) << 6) | (((lane >> 4) & 1) << 5) | (((lane >> 5) & 1) << 8); }
constexpr int v_rd_off(int d0, int ks, int half) { return d0 * 512 + ks * 4096 + half * 2048; }
template <int OFF> __device__ __forceinline__ s16x4 tr_read(int vb) {
  s16x4 r; asm volatile("ds_read_b64_tr_b16 %0, %1 offset:%2" : "=&v"(r) : "v"(vb), "i"(OFF) : "memory"); return r;
}
template <int D0> __device__ __forceinline__ void pv_one(f32x16& od, int vb, bf16x8 pa0, bf16x8 pa1, bf16x8 pa2, bf16x8 pa3) {
  const s16x4 l0 = tr_read<v_rd_off(D0, 0, 0)>(vb), h0 = tr_read<v_rd_off(D0, 0, 1)>(vb), l1 = tr_read<v_rd_off(D0, 1, 0)>(vb), h1 = tr_read<v_rd_off(D0, 1, 1)>(vb);
  const s16x4 l2 = tr_read<v_rd_off(D0, 2, 0)>(vb), h2 = tr_read<v_rd_off(D0, 2, 1)>(vb), l3 = tr_read<v_rd_off(D0, 3, 0)>(vb), h3 = tr_read<v_rd_off(D0, 3, 1)>(vb);
  asm volatile("s_waitcnt lgkmcnt(0)" ::: "memory"); SBAR();
#define PK(L, H) (bf16x8){L[0], L[1], L[2], L[3], H[0], H[1], H[2], H[3]}
  od = __builtin_amdgcn_mfma_f32_32x32x16_bf16(pa0, PK(l0, h0), od, 0, 0, 0);
  od = __builtin_amdgcn_mfma_f32_32x32x16_bf16(pa1, PK(l1, h1), od, 0, 0, 0);
  od = __builtin_amdgcn_mfma_f32_32x32x16_bf16(pa2, PK(l2, h2), od, 0, 0, 0);
  od = __builtin_amdgcn_mfma_f32_32x32x16_bf16(pa3, PK(l3, h3), od, 0, 0, 0);
#undef PK
}
__device__ __forceinline__ void pv_d0(f32x16* o, int vb, bf16x8 pa0, bf16x8 pa1, bf16x8 pa2, bf16x8 pa3) {
  pv_one<0>(o[0], vb, pa0, pa1, pa2, pa3); pv_one<1>(o[1], vb, pa0, pa1, pa2, pa3); pv_one<2>(o[2], vb, pa0, pa1, pa2, pa3); pv_one<3>(o[3], vb, pa0, pa1, pa2, pa3);
}

__device__ __forceinline__ void attn_unit(const bf16_t* __restrict__ Qb, const bf16_t* __restrict__ Kn, const bf16_t* __restrict__ Vh, const bf16_t* __restrict__ Kr,
                                          const bf16_t* __restrict__ Mz, bf16_t* __restrict__ Ob, int NT, char* lds, LAS unsigned char* lds3) {
  const int tid = tid_fresh(), wid = __builtin_amdgcn_readfirstlane(tid >> 6), lane = tid & 63, r32 = lane & 31, hi = lane >> 5;
  char* V_lds = lds; char* K_lds = lds + OFF_K; char* R_lds = lds + OFF_R;
  float* ws = (float*)(lds + OFF_WS) + wid * 64; float* li_l = ws; float* al_l = ws + 32;
  const float NEGBIG = opaque_f(-1e30f);
  float m_reg = NEGBIG, l_reg = 0; f32x16 o[4] = {}; bf16x8 qr[12];
  const bf16_t* Qw = Qb + (long)(wid * 32 + r32) * LDQ + hi * 8;
#pragma unroll
  for (int d0 = 0; d0 < 12; ++d0) qr[d0] = *reinterpret_cast<const bf16x8*>(Qw + d0 * 16);
  const int vb0 = (int)(uintptr_t)V_lds + v_rd_base(lane);
  unsigned gK[2], gV[2], gR;
#pragma unroll
  for (int i = 0; i < 2; ++i) {
    const int pc = wid * 2 + i;
    { const int row = pc * 4 + (lane >> 4), colB = ((lane & 15) << 4) ^ ((row & 7) << 4); gK[i] = (unsigned)(row * LDKV + (colB >> 1)); }
    { const int st = pc * 2 + (lane >> 5), kk = (st >> 2) * 8 + ((lane & 31) >> 2), c = (st & 3) * 32 + (lane & 3) * 8;
      const int k = (kk & ~0xC) | ((kk & 4) << 1) | ((kk & 8) >> 1); gV[i] = (unsigned)(k * LDKV + c); }
  }
  { const int row = wid * 8 + (lane >> 3), colB = ((lane & 7) << 4) ^ ((row & 7) << 4); gR = (unsigned)(row * LDP + (colB >> 1)); }
  LAS unsigned char* dV = lds3 + wid * 2048; LAS unsigned char* dK = lds3 + OFF_K + wid * 2048; LAS unsigned char* dR = lds3 + OFF_R + wid * 1024;
#define DMA_KR(b, k0) do { const bf16_t* _k = Kn + (long)(k0) * LDKV; const bf16_t* _r = Kr + (long)(k0) * LDP; \
    __builtin_amdgcn_global_load_lds((const unsigned*)(_k + gK[0]), (LAS unsigned*)(dK + (b) * SHM_K), 16, 0, 0); \
    __builtin_amdgcn_global_load_lds((const unsigned*)(_k + gK[1]), (LAS unsigned*)(dK + (b) * SHM_K + 1024), 16, 0, 0); \
    __builtin_amdgcn_global_load_lds((const unsigned*)(_r + gR), (LAS unsigned*)(dR + (b) * SHM_R), 16, 0, 0); } while (0)
#define DMA_V(b, k0) do { const bf16_t* _v = Vh + (long)(k0) * LDKV; \
    __builtin_amdgcn_global_load_lds((const unsigned*)(_v + gV[0]), (LAS unsigned*)(dV + (b) * SHM_V), 16, 0, 0); \
    __builtin_amdgcn_global_load_lds((const unsigned*)(_v + gV[1]), (LAS unsigned*)(dV + (b) * SHM_V + 1024), 16, 0, 0); } while (0)
#define VWAIT(n) asm volatile("s_waitcnt vmcnt(" #n ")" ::: "memory")
#define RBAR() do { asm volatile("s_waitcnt lgkmcnt(0)" ::: "memory"); __builtin_amdgcn_s_barrier(); asm volatile("" ::: "memory"); SBAR(); } while (0)
#define RESC(a) do { if (__any((a) < 1.f)) { if (hi == 0) al_l[r32] = (a); asm volatile("s_waitcnt lgkmcnt(0)" ::: "memory"); \
    _Pragma("unroll") for (int d = 0; d < 4; ++d) _Pragma("unroll") for (int r = 0; r < 16; ++r) o[d][r] *= al_l[crow(r, hi)]; } } while (0)
  f32x16 pA0, pA1, pB0, pB1; float mnA, mnB, alA, alB; bf16x8 pa0, pa1, pa2, pa3;
  RBAR();
  DMA_KR(0, 0); DMA_V(0, 0); DMA_KR(1, KVBLK); DMA_V(1, KVBLK);
  VWAIT(5); RBAR();
  qkt(pA0, pA1, K_lds, R_lds, qr, r32, hi);
#pragma unroll
  for (int r = 0; r < 16; ++r) pA0[r] = NEGBIG;
#pragma unroll
  for (int r = 0; r < 8; ++r) pA1[r] = NEGBIG;
  partialSM(pA0, pA1, m_reg, mnA, alA);
  VWAIT(0); RBAR();
  for (int j = 1; j + 1 < NT; j += 2) {
    DMA_KR(0, (j + 1) * KVBLK);
    SBAR(); qkt(pB0, pB1, K_lds + SHM_K, R_lds + SHM_R, qr, r32, hi);
    finishSM(pA0, pA1, alA, l_reg, pa0, pa1, pa2, pa3); SBAR();
    pv_d0(o, vb0, pa0, pa1, pa2, pa3); partialSM(pB0, pB1, m_reg, mnB, alB);
    RBAR();
    DMA_V(0, (j + 1) * KVBLK);
    RESC(alB);
    VWAIT(2); RBAR();
    const bool more = (j + 2 < NT);
    if (more) DMA_KR(1, (j + 2) * KVBLK);
    SBAR(); qkt(pA0, pA1, K_lds, R_lds, qr, r32, hi);
    finishSM(pB0, pB1, alB, l_reg, pa0, pa1, pa2, pa3); SBAR();
    pv_d0(o, vb0 + SHM_V, pa0, pa1, pa2, pa3); partialSM(pA0, pA1, m_reg, mnA, alA);
    RBAR();
    if (more) DMA_V(1, (j + 2) * KVBLK);
    RESC(alA);
    if (more) VWAIT(2); else VWAIT(0);
    RBAR();
  }
  finishSM(pA0, pA1, alA, l_reg, pa0, pa1, pa2, pa3); SBAR();
  pv_d0(o, vb0, pa0, pa1, pa2, pa3);
  if (hi == 0) li_l[r32] = l_reg; asm volatile("s_waitcnt lgkmcnt(0)" ::: "memory");
  float rli[16];
#pragma unroll
  for (int r = 0; r < 16; ++r) rli[r] = __builtin_amdgcn_rcpf(li_l[crow(r, hi)]);
  bf16_t* Ow = Ob + (long)(wid * 32) * LDO; const bf16_t* Mw = Mz + (long)(wid * 32) * LDP;
  float* wbuf = (float*)(lds + SHM_V + wid * 8192);
  u32x4 zv[2][4];
#pragma unroll
  for (int ps = 0; ps < 2; ++ps)
#pragma unroll
    for (int i = 0; i < 4; ++i) { const int c = i * 64 + lane, row = ps * 16 + (c >> 4), cc = (c & 15) * 8; zv[ps][i] = *(const u32x4*)(Mw + (long)row * LDP + cc); }
#pragma unroll
  for (int ps = 0; ps < 2; ++ps) {
#pragma unroll
    for (int rr = 0; rr < 8; ++rr) { const int r = ps * 8 + rr, lrow = crow(r, hi) - ps * 16;
#pragma unroll
      for (int d0 = 0; d0 < 4; ++d0) wbuf[lrow * 128 + d0 * 32 + r32] = o[d0][r] * rli[r]; }
#pragma unroll
    for (int i = 0; i < 4; ++i) { const int c = i * 64 + lane, lrow = c >> 4, cc = (c & 15) * 8;
      const f32x4 v0 = *(const f32x4*)(wbuf + lrow * 128 + cc), v1 = *(const f32x4*)(wbuf + lrow * 128 + cc + 4);
      const u32x4 z = zv[ps][i];
      u32x4 w;
      w[0] = cvt_pk_bf16(v0[0] * siluf_(bflo(z[0])), v0[1] * siluf_(bfhi(z[0]))); w[1] = cvt_pk_bf16(v0[2] * siluf_(bflo(z[1])), v0[3] * siluf_(bfhi(z[1])));
      w[2] = cvt_pk_bf16(v1[0] * siluf_(bflo(z[2])), v1[1] * siluf_(bfhi(z[2]))); w[3] = cvt_pk_bf16(v1[2] * siluf_(bflo(z[3])), v1[3] * siluf_(bfhi(z[3])));
      *(u32x4*)(Ow + (long)(ps * 16 + lrow) * LDO + cc) = w; }
  }
#undef DMA_KR
#undef DMA_V
#undef VWAIT
#undef RBAR
#undef RESC
}
}

__device__ void ln_h_phase(const Params& p, int c, bf16_t* hb) {
  const Chunk ck = get_chunk(p, c);
  const int lane = tid_fresh() & 63, gw = blockIdx.x * 8 + (tid_fresh() >> 6), nw = gridDim.x * 8, nrows = ck.nPp * 256;
  for (int r0 = gw * 4; r0 < nrows; r0 += nw * 4) {
    f32x4 v[4][4]; int tt[4], sq[4];
#pragma unroll
    for (int j = 0; j < 4; ++j) { const int r = r0 + j; sq[j] = r / ck.Lp; tt[j] = r % ck.Lp - 48;
      const int t = tt[j] < 0 ? 0 : tt[j];
      const float* src = (t < 16 ? p.meta + (size_t)t * DM : ck.x + ((size_t)sq[j] * ck.S + (t - 16)) * DM) + lane * 8;
      v[j][0] = *(const f32x4*)src; v[j][1] = *(const f32x4*)(src + 4); v[j][2] = *(const f32x4*)(src + 512); v[j][3] = *(const f32x4*)(src + 516); }
#pragma unroll
    for (int j = 0; j < 4; ++j) {
      bf16_t* dst = hb + (size_t)(r0 + j) * DM + lane * 8;
      if (tt[j] < 0) { *(u32x4*)dst = (u32x4){0, 0, 0, 0}; *(u32x4*)(dst + 512) = (u32x4){0, 0, 0, 0}; continue; }
      float s = 0;
#pragma unroll
      for (int i = 0; i < 4; ++i) s += v[j][i][0] + v[j][i][1] + v[j][i][2] + v[j][i][3];
      const float mu = wave_sum(s, lane) * (1.f / 1024.f);
      float q = 0;
#pragma unroll
      for (int i = 0; i < 4; ++i) { v[j][i] = v[j][i] - mu; q += v[j][i][0] * v[j][i][0] + v[j][i][1] * v[j][i][1] + v[j][i][2] * v[j][i][2] + v[j][i][3] * v[j][i][3]; }
      const float rstd = rsqrtf(wave_sum(q, lane) * (1.f / 1024.f) + opaque_f(1e-5f));
      f32x4 y[4];
#pragma unroll
      for (int i = 0; i < 4; ++i) { const int col = lane * 8 + (i >> 1) * 512 + (i & 1) * 4;
        y[i] = v[j][i] * rstd * *(const f32x4*)(p.emb_g + col) + *(const f32x4*)(p.emb_b + col); }
      *(u32x4*)dst = pack8(y[0], y[1]); *(u32x4*)(dst + 512) = pack8(y[2], y[3]);
      if (tt[j] >= 16 && lane == 0) p.lnstat[ck.crow0 + sq[j] * ck.S + (tt[j] - 16)] = make_float2(mu, rstd);
    }
  }
}
__device__ void final_ln_phase(const Params& p, int c) {
  const Chunk ck = get_chunk(p, c);
  const int lane = tid_fresh() & 63, gw = blockIdx.x * 8 + (tid_fresh() >> 6), nw = gridDim.x * 8;
  for (int r0 = gw * 4; r0 < CMAX; r0 += nw * 4) {
    f32x4 v[4][4];
#pragma unroll
    for (int j = 0; j < 4; ++j) { const float* row = p.out + (size_t)(ck.crow0 + r0 + j) * DM + lane * 4;
#pragma unroll
      for (int i = 0; i < 4; ++i) v[j][i] = *(const f32x4*)(row + i * 256); }
#pragma unroll
    for (int j = 0; j < 4; ++j) {
      float* row = p.out + (size_t)(ck.crow0 + r0 + j) * DM + lane * 4;
      float s = 0;
#pragma unroll
      for (int i = 0; i < 4; ++i) s += v[j][i][0] + v[j][i][1] + v[j][i][2] + v[j][i][3];
      const float mu = wave_sum(s, lane) * (1.f / 1024.f);
      float q = 0;
#pragma unroll
      for (int i = 0; i < 4; ++i) { v[j][i] = v[j][i] - mu; q += v[j][i][0] * v[j][i][0] + v[j][i][1] * v[j][i][1] + v[j][i][2] * v[j][i][2] + v[j][i][3] * v[j][i][3]; }
      const float rstd = rsqrtf(wave_sum(q, lane) * (1.f / 1024.f) + opaque_f(1e-5f));
#pragma unroll
      for (int i = 0; i < 4; ++i) { const int col = lane * 4 + i * 256;
        *(f32x4*)(row + i * 256) = v[j][i] * rstd * *(const f32x4*)(p.pln_g + col) + *(const f32x4*)(p.pln_b + col); }
    }
  }
}

template <class SrcFn>
__device__ void cvt_wt(const float* __restrict__ W, int ldw, int K, int N, bf16_t* __restrict__ Wt, const float* __restrict__ kscale, SrcFn src, char* lds, int ldt = 0) {
  if (ldt == 0) ldt = K;
  bf16_t* tl = (bf16_t*)lds;
  const int tid = tid_fresh(), nTn = N / 64, nTk = K / 64;
  for (int tile = blockIdx.x; tile < nTn * nTk; tile += gridDim.x) {
    const int tn = tile % nTn, tk = tile / nTn;
    { const int n = tid & 63, kk = tid >> 6; const int s = src(tn * 64 + n);
#pragma unroll
      for (int it = 0; it < 8; ++it) { const int kl = it * 8 + kk, k = tk * 64 + kl;
        float val = 0.f; if (s >= 0) { val = W[(size_t)k * ldw + s]; if (kscale) val *= kscale[k]; }
        tl[n * 66 + kl] = f2bf(val); } }
    __syncthreads();
    { const int n = tid >> 3, k8 = (tid & 7) * 8; const bf16_t* r = tl + n * 66 + k8;
      u32x4 w = {(unsigned)r[0] | ((unsigned)r[1] << 16), (unsigned)r[2] | ((unsigned)r[3] << 16), (unsigned)r[4] | ((unsigned)r[5] << 16), (unsigned)r[6] | ((unsigned)r[7] << 16)};
      *(u32x4*)(Wt + (size_t)(tn * 64 + n) * ldt + tk * 64 + k8) = w; }
    __syncthreads();
  }
}
__device__ __forceinline__ int src_w1(int n) {
  if (n < 3072) return n;
  if (n < 6144) return n - 3072 + 3808;
  if (n < 6528) return n - 6144 + 3104;
  if (n < 6784) return n - 6528 + 3488;
  if (n < 6848) { const int j = n - 6784; return 3744 + (j >> 1) + 32 * (j & 1); }
  if (n < 6864) return 3072 + (n - 6848);
  if (n < 6880) return 3088 + (n - 6864);
  return -1;
}
__device__ __forceinline__ int src_wq(int n) { const int h = n / 192, j = n % 192; if (j < 128) return n; const int jj = j - 128; return h * 192 + 128 + (jj >> 1) + 32 * (jj & 1); }
__device__ __forceinline__ int src_id(int n) { return n; }

__device__ void prep_phase(const Params& p, char* lds) {
  cvt_wt(p.w_in, 6880, 1024, NPROJ, p.W1t, nullptr, src_w1, lds);
  cvt_wt(p.w_q_b, 1536, 384, 1536, p.Wqt, p.q_g, src_wq, lds);
  cvt_wt(p.w_kv_b, 2048, 256, 2048, p.Wkvt, p.kv_g, src_id, lds);
  cvt_wt(p.w_o_gla, 1024, 1024, 1024, p.Wcat, nullptr, src_id, lds, 2048);
  cvt_wt(p.w_o_mla, 1024, 1024, 1024, p.Wcat + 1024, nullptr, src_id, lds, 2048);
  cvt_wt(p.w_out, 1024, 1024, 1024, p.Woutt, nullptr, src_id, lds);
  for (int i = blockIdx.x * 512 + tid_fresh(); i < NPOS * 32; i += gridDim.x * 512) {
    const int pos = i >> 5, f = i & 31;
    const double inv = pow(10000.0, -(double)(2 * f) / 64.0), ang = (double)pos * inv;
    p.cosT[i] = (float)cos(ang); p.sinT[i] = (float)sin(ang);
  }
}

#define SBAR_LDS() do { asm volatile("s_waitcnt lgkmcnt(0)" ::: "memory"); __builtin_amdgcn_s_barrier(); asm volatile("" ::: "memory"); } while (0)
__device__ void stats_phase(const Params& p, const Chunk& ck, char* lds) {
  const int tid = tid_fresh(), lane = tid & 63, wid = tid >> 6, nrows = ck.nPp * 256;
  { const int gw = blockIdx.x * 8 + wid, nw = gridDim.x * 8;
    for (int r0 = gw * 8; r0 < nrows; r0 += nw * 8) {
      unsigned q3[8][3], k2[8][2];
#pragma unroll
      for (int i = 0; i < 8; ++i) { const bf16_t* pr = p.proj + (size_t)(r0 + i) * NPROJ;
#pragma unroll
        for (int j = 0; j < 3; ++j) q3[i][j] = ((const unsigned*)(pr + C_CQ))[lane * 3 + j];
#pragma unroll
        for (int j = 0; j < 2; ++j) k2[i][j] = ((const unsigned*)(pr + C_CKV))[lane * 2 + j]; }
#pragma unroll
      for (int i = 0; i < 8; ++i) { float s = 0, s2 = 0;
#pragma unroll
        for (int j = 0; j < 3; ++j) { const float a = bflo(q3[i][j]), b = bfhi(q3[i][j]); s += a * a + b * b; }
#pragma unroll
        for (int j = 0; j < 2; ++j) { const float a = bflo(k2[i][j]), b = bfhi(k2[i][j]); s2 += a * a + b * b; }
        s = wave_sum(s, lane); s2 = wave_sum(s2, lane);
        if (lane == 0) { p.rstdq[r0 + i] = rsqrtf(s * (1.f / 384.f) + opaque_f(1e-6f)); p.rstdkv[r0 + i] = rsqrtf(s2 * (1.f / 256.f) + opaque_f(1e-6f)); } }
    } }
  bf16_t* glt = (bf16_t*)lds;
  float* offs = (float*)(lds + 4096);
  const int col = tid & 127, rg = tid >> 7, nunits = ck.nPp * 4 * 8;
  u32x4 stg = {0, 0, 0, 0}; float w[16]; float bias = 0.f;
  auto uload = [&](int unit) {
    const int rcn = unit >> 3, dir = (unit >> 2) & 1, head = unit & 3;
    if (tid < 256) stg = *(const u32x4*)(p.proj + (size_t)(rcn * 64 + (tid >> 2)) * NPROJ + C_GLF + (tid & 3) * 8);
    const float* wg = (dir ? p.wgb : p.wgf) + head * 128 + col;
#pragma unroll
    for (int j = 0; j < 16; ++j) w[j] = wg[j * 512];
    bias = (dir ? p.bgb : p.bgf)[head * 128 + col];
  };
  if ((int)blockIdx.x < nunits) uload(blockIdx.x);
  for (int unit = blockIdx.x; unit < nunits; unit += gridDim.x) {
    const int rcn = unit >> 3, dir = (unit >> 2) & 1, head = unit & 3;
    SBAR_LDS();
    if (tid < 256) *(u32x4*)(glt + (tid >> 2) * 32 + (tid & 3) * 8) = stg;
    float wc_[16]; const float bias_c = bias;
#pragma unroll
    for (int j = 0; j < 16; ++j) wc_[j] = w[j];
    SBAR_LDS();
    if (unit + (int)gridDim.x < nunits) uload(unit + gridDim.x);
    const int tq = (rcn * 64) % ck.Lp;
    float v[16];
#pragma unroll
    for (int i = 0; i < 16; ++i) { const int row = rg * 16 + i;
      const u32x4 x0 = *(const u32x4*)(glt + row * 32 + dir * 16), x1 = *(const u32x4*)(glt + row * 32 + dir * 16 + 8);
      float pre = bias_c;
#pragma unroll
      for (int j = 0; j < 4; ++j) { pre = fmaf(bflo(x0[j]), wc_[2 * j], pre); pre = fmaf(bfhi(x0[j]), wc_[2 * j + 1], pre); }
#pragma unroll
      for (int j = 0; j < 4; ++j) { pre = fmaf(bflo(x1[j]), wc_[8 + 2 * j], pre); pre = fmaf(bfhi(x1[j]), wc_[8 + 2 * j + 1], pre); }
      const float g = (fminf(pre, 0.f) - __logf(1.f + __expf(-fabsf(pre)))) * 0.0625f;
      v[i] = (tq + row < 48) ? 0.f : g; }
    if (dir == 0) {
#pragma unroll
      for (int i = 1; i < 16; ++i) v[i] += v[i - 1];
      offs[rg * 128 + col] = v[15];
    } else {
#pragma unroll
      for (int i = 14; i >= 0; --i) v[i] += v[i + 1];
      offs[rg * 128 + col] = v[0];
    }
    SBAR_LDS();
    float add = 0.f;
#pragma unroll
    for (int g2 = 0; g2 < 4; ++g2) { const float o = offs[g2 * 128 + col]; if (dir == 0 ? (g2 < rg) : (g2 > rg)) add += o; }
    float* dst = (dir ? p.gB : p.gF) + (size_t)(rcn * 64 + rg * 16) * 512 + head * 128 + col;
#pragma unroll
    for (int i = 0; i < 16; ++i) dst[(size_t)i * 512] = v[i] + add;
  }
  __syncthreads();
}

namespace gla {
constexpr int OFF_Q = 0, OFF_K = 16384, OFF_V = 32768, OFF_P = 45056, OFF_S = 53248, OFF_OT = 77824;
__device__ __forceinline__ int fb(int row) { return ((row & 3) << 2) | ((row >> 2) & 3); }
__device__ __forceinline__ int koff(int row, int ch) { return 256 * row + 16 * (ch ^ fb(row)); }
__device__ __forceinline__ s16x4 trr(int addr) { s16x4 r; asm volatile("ds_read_b64_tr_b16 %0, %1" : "=&v"(r) : "v"(addr) : "memory"); return r; }
#define GPK(L, H) (bf16x8){L[0], L[1], L[2], L[3], H[0], H[1], H[2], H[3]}
#define GWAITL() do { asm volatile("s_waitcnt lgkmcnt(0)" ::: "memory"); __builtin_amdgcn_sched_barrier(0); } while (0)
#define GBAR() do { asm volatile("s_waitcnt lgkmcnt(0)" ::: "memory"); __builtin_amdgcn_s_barrier(); asm volatile("" ::: "memory"); __builtin_amdgcn_sched_barrier(0); } while (0)

__device__ void item(const Params& p, const Chunk& ck, int it_, char* lds) {
  const int dvq = it_ & 3, dir = (it_ >> 2) & 1, head = (it_ >> 3) & 3, seq = it_ >> 5;
  const int tid = tid_fresh(), wid = __builtin_amdgcn_readfirstlane(tid >> 6), lane = tid & 63, r32 = lane & 31, hi = lane >> 5;
  const int ldsb = (int)(uintptr_t)lds;
  const int NC = ck.Lp / 64;
  const bf16_t* pbase = p.proj + (size_t)(seq * ck.Lp) * NPROJ;
  const float* gbase = (dir ? p.gB : p.gF) + (size_t)(seq * ck.Lp) * 512 + head * 128;
  bf16_t* obase = (dir ? p.Ob : p.Of) + (size_t)(seq * ck.S) * 1024 + head * 256 + dvq * 64;
  const int er = tid >> 4, ec = (tid & 15) * 8, vr = tid >> 3, vc = (tid & 7) * 8;
  const int midrow = dir ? 31 : 32, lastrow = dir ? 0 : 63;
  const int dt = wid >> 2, kt = wid & 3, dkl = kt * 32 + r32;
  f32x16 St = {};
  const int trow = 8 * hi + ((lane & 15) >> 2), tcol = 16 * ((lane >> 4) & 1) + 4 * (lane & 3);
  const int QS_ = 0; (void)QS_;
  const float QS = 0.08838834764831845f;
  struct Pre { u32x4 rq0, rq1, rk0, rk1, rv; f32x4 rb0a, rb0b, rb1a, rb1b, rma, rmb; float rmid, rlast; };
  Pre R0, R1;
  auto gload = [&](int chunk, Pre& r) {
    const bf16_t* pr = pbase + (size_t)(chunk * 64) * NPROJ; const float* gr = gbase + (size_t)(chunk * 64) * 512;
    r.rq0 = *(const u32x4*)(pr + (size_t)er * NPROJ + C_GQ + head * 128 + ec); r.rq1 = *(const u32x4*)(pr + (size_t)(er + 32) * NPROJ + C_GQ + head * 128 + ec);
    r.rk0 = *(const u32x4*)(pr + (size_t)er * NPROJ + C_GK + head * 128 + ec); r.rk1 = *(const u32x4*)(pr + (size_t)(er + 32) * NPROJ + C_GK + head * 128 + ec);
    r.rv = *(const u32x4*)(pr + (size_t)vr * NPROJ + C_GV + head * 256 + dvq * 64 + vc);
    r.rb0a = *(const f32x4*)(gr + (size_t)er * 512 + ec); r.rb0b = *(const f32x4*)(gr + (size_t)er * 512 + ec + 4);
    r.rb1a = *(const f32x4*)(gr + (size_t)(er + 32) * 512 + ec); r.rb1b = *(const f32x4*)(gr + (size_t)(er + 32) * 512 + ec + 4);
    r.rma = *(const f32x4*)(gr + (size_t)midrow * 512 + ec); r.rmb = *(const f32x4*)(gr + (size_t)midrow * 512 + ec + 4);
    r.rmid = gr[(size_t)midrow * 512 + dkl]; r.rlast = gr[(size_t)lastrow * 512 + dkl];
  };
  const int nsteps = dir ? NC - 1 : NC;
  gload(dir ? NC - 1 : 0, R0); gload(dir ? NC - 2 : 1, R1);
  __syncthreads();
  auto body = [&](int st, Pre& r) {
    u32x4& rq0 = r.rq0; u32x4& rq1 = r.rq1; u32x4& rk0 = r.rk0; u32x4& rk1 = r.rk1; u32x4& rv = r.rv;
    f32x4& rb0a = r.rb0a; f32x4& rb0b = r.rb0b; f32x4& rb1a = r.rb1a; f32x4& rb1b = r.rb1b; f32x4& rma = r.rma; f32x4& rmb = r.rmb; float& rmid = r.rmid; float& rlast = r.rlast;
    const int chunk = dir ? NC - 1 - st : st;
    { float e[8]; f32x4 ba = rb0a - rma, bb = rb0b - rmb;
#pragma unroll
      for (int i = 0; i < 4; ++i) { e[i] = __expf(ba[i]); e[4 + i] = __expf(bb[i]); }
      u32x4 wq, wk;
#pragma unroll
      for (int i = 0; i < 4; ++i) { const float r0 = __builtin_amdgcn_rcpf(e[2 * i]), r1 = __builtin_amdgcn_rcpf(e[2 * i + 1]);
        wq[i] = cvt_pk_bf16(bflo(rq0[i]) * QS * e[2 * i], bfhi(rq0[i]) * QS * e[2 * i + 1]); wk[i] = cvt_pk_bf16(bflo(rk0[i]) * r0, bfhi(rk0[i]) * r1); }
      *(u32x4*)(lds + OFF_Q + KSWZ(er, ec * 2)) = wq; *(u32x4*)(lds + OFF_K + koff(er, ec >> 3)) = wk;
      ba = rb1a - rma; bb = rb1b - rmb;
#pragma unroll
      for (int i = 0; i < 4; ++i) { e[i] = __expf(ba[i]); e[4 + i] = __expf(bb[i]); }
#pragma unroll
      for (int i = 0; i < 4; ++i) { const float r0 = __builtin_amdgcn_rcpf(e[2 * i]), r1 = __builtin_amdgcn_rcpf(e[2 * i + 1]);
        wq[i] = cvt_pk_bf16(bflo(rq1[i]) * QS * e[2 * i], bfhi(rq1[i]) * QS * e[2 * i + 1]); wk[i] = cvt_pk_bf16(bflo(rk1[i]) * r0, bfhi(rk1[i]) * r1); }
      *(u32x4*)(lds + OFF_Q + KSWZ(er + 32, ec * 2)) = wq; *(u32x4*)(lds + OFF_K + koff(er + 32, ec >> 3)) = wk;
      *(u32x4*)(lds + OFF_V + vr * 192 + vc * 2) = rv; }
    const float c1 = __expf(rmid), dec = __expf(rlast), c2 = __expf(rlast - rmid);
#pragma unroll
    for (int rq = 0; rq < 4; ++rq) { const int dv0 = dt * 32 + 8 * rq + 4 * hi;
      uint2 w; w.x = cvt_pk_bf16(St[4 * rq] * c1, St[4 * rq + 1] * c1); w.y = cvt_pk_bf16(St[4 * rq + 2] * c1, St[4 * rq + 3] * c1);
      *(uint2*)(lds + OFF_S + dkl * 192 + dv0 * 2) = w; }
    GBAR();
    if (st + 2 < nsteps) gload(dir ? NC - 3 - st : st + 2, r);
    f32x16 accX = {}, accT = {};
    if (wid < 4) {
      const int jt = wid >> 1, it = wid & 1;
      const int krow = jt * 32 + r32, kbase = ldsb + OFF_K + 256 * krow, kf = fb(krow);
      const int qbase = ldsb + OFF_Q + (it * 32 + r32) * 256, qs = (r32 & 7) << 4;
      bf16x8 fa[8], fq[8];
#define GP_LOAD(ks) do { fa[ks] = att::ds128<0>(kbase + 16 * ((2 * (ks) + hi) ^ kf)); fq[ks] = att::ds128<0>(qbase + ((((ks) * 32) + hi * 16) ^ qs)); } while (0)
      GP_LOAD(0);
#pragma unroll
      for (int ks = 0; ks < 8; ++ks) {
        if (ks + 1 < 8) GP_LOAD(ks + 1);
        if (ks < 7) asm volatile("s_waitcnt lgkmcnt(2)" ::: "memory"); else asm volatile("s_waitcnt lgkmcnt(0)" ::: "memory");
        __builtin_amdgcn_sched_barrier(0);
        accX = __builtin_amdgcn_mfma_f32_32x32x16_bf16(fa[ks], fq[ks], accX, 0, 0, 0); }
#undef GP_LOAD
    } else {
      const int it = (wid - 4) >> 1, dto = (wid - 4) & 1;
      const int sb = ldsb + OFF_S + trow * 192 + (dto * 32 + tcol) * 2;
      const int qbase = ldsb + OFF_Q + (it * 32 + r32) * 256, qs = (r32 & 7) << 4;
      s16x4 sl[8], sh[8]; bf16x8 fq[8];
#define GO_LOAD(ks) do { sl[ks] = trr(sb + (ks) * 16 * 192); sh[ks] = trr(sb + (ks) * 16 * 192 + 4 * 192); fq[ks] = att::ds128<0>(qbase + ((((ks) * 32) + hi * 16) ^ qs)); } while (0)
      GO_LOAD(0);
#pragma unroll
      for (int ks = 0; ks < 8; ++ks) {
        if (ks + 1 < 8) GO_LOAD(ks + 1);
        if (ks < 7) asm volatile("s_waitcnt lgkmcnt(3)" ::: "memory"); else asm volatile("s_waitcnt lgkmcnt(0)" ::: "memory");
        __builtin_amdgcn_sched_barrier(0);
        accX = __builtin_amdgcn_mfma_f32_32x32x16_bf16(fq[ks], GPK(sl[ks], sh[ks]), accX, 0, 0, 0); }
#undef GO_LOAD
    }
    {
      const int vb = ldsb + OFF_V + trow * 192 + (dt * 32 + tcol) * 2;
      const int chb = kt * 4 + 2 * ((lane >> 4) & 1) + ((lane & 3) >> 1);
      const int kb0 = ldsb + OFF_K + 256 * trow + 16 * (chb ^ fb(trow)) + 8 * (lane & 1), kb1 = ldsb + OFF_K + 256 * (trow + 4) + 16 * (chb ^ fb(trow + 4)) + 8 * (lane & 1);
      s16x4 al[4], ah[4], bl[4], bh[4];
#define GT_LOAD(ks) do { al[ks] = trr(vb + (ks) * 16 * 192); ah[ks] = trr(vb + (ks) * 16 * 192 + 4 * 192); bl[ks] = trr(kb0 + (ks) * 16 * 256); bh[ks] = trr(kb1 + (ks) * 16 * 256); } while (0)
      GT_LOAD(0);
#pragma unroll
      for (int ks = 0; ks < 4; ++ks) {
        if (ks + 1 < 4) GT_LOAD(ks + 1);
        if (ks < 3) asm volatile("s_waitcnt lgkmcnt(4)" ::: "memory"); else asm volatile("s_waitcnt lgkmcnt(0)" ::: "memory");
        __builtin_amdgcn_sched_barrier(0);
        accT = __builtin_amdgcn_mfma_f32_32x32x16_bf16(GPK(al[ks], ah[ks]), GPK(bl[ks], bh[ks]), accT, 0, 0, 0); }
#undef GT_LOAD
    }
    if (wid < 4) {
      const int jt = wid >> 1, it = wid & 1, i = it * 32 + r32;
#pragma unroll
      for (int rq = 0; rq < 4; ++rq) { const int j0 = jt * 32 + 8 * rq + 4 * hi; float v[4];
#pragma unroll
        for (int e = 0; e < 4; ++e) { const int j = j0 + e; const bool keep = dir ? (j > i) : (j <= i); v[e] = keep ? accX[4 * rq + e] : 0.f; }
        uint2 w; w.x = cvt_pk_bf16(v[0], v[1]); w.y = cvt_pk_bf16(v[2], v[3]);
        *(uint2*)(lds + OFF_P + RSWZ(i, j0 * 2)) = w; }
    }
    GBAR();
    if (wid >= 4) {
      const int it = (wid - 4) >> 1, dto = (wid - 4) & 1;
      const int vb = ldsb + OFF_V + trow * 192 + (dto * 32 + tcol) * 2;
      const int pbase_ = ldsb + OFF_P + (it * 32 + r32) * 128, ps = (r32 & 7) << 4;
      s16x4 vl[4], vh[4]; bf16x8 pa[4];
#define GB_LOAD(ks) do { vl[ks] = trr(vb + (ks) * 16 * 192); vh[ks] = trr(vb + (ks) * 16 * 192 + 4 * 192); pa[ks] = att::ds128<0>(pbase_ + ((((ks) * 32) + hi * 16) ^ ps)); } while (0)
      GB_LOAD(0);
#pragma unroll
      for (int ks = 0; ks < 4; ++ks) {
        if (ks + 1 < 4) GB_LOAD(ks + 1);
        if (ks < 3) asm volatile("s_waitcnt lgkmcnt(3)" ::: "memory"); else asm volatile("s_waitcnt lgkmcnt(0)" ::: "memory");
        __builtin_amdgcn_sched_barrier(0);
        accX = __builtin_amdgcn_mfma_f32_32x32x16_bf16(pa[ks], GPK(vl[ks], vh[ks]), accX, 0, 0, 0); }
#undef GB_LOAD
      if (chunk >= 1) {
        float* wbuf = (float*)(lds + OFF_OT + (wid - 4) * 4096);
#pragma unroll
        for (int r = 0; r < 16; ++r) wbuf[att::crow(r, hi) * 32 + r32] = accX[r];
        bf16_t* op = obase + (size_t)((chunk - 1) * 64 + it * 32) * 1024 + dto * 32;
#pragma unroll
        for (int i = 0; i < 2; ++i) { const int c = i * 64 + lane, row = c >> 2, cc = (c & 3) * 8;
          const f32x4 v0 = *(const f32x4*)(wbuf + row * 32 + cc), v1 = *(const f32x4*)(wbuf + row * 32 + cc + 4);
          *(u32x4*)(op + (size_t)row * 1024 + cc) = pack8(v0, v1); }
      }
    }
#pragma unroll
    for (int r2 = 0; r2 < 16; ++r2) St[r2] = St[r2] * dec + c2 * accT[r2];
    GBAR();
  };
  for (int st = 0; st < nsteps; st += 2) { body(st, R0); if (st + 1 < nsteps) body(st + 1, R1); }
}
#undef GPK
#undef GWAITL
#undef GBAR
}

__device__ void combine_phase(const Params& p, const Chunk& ck) {
  const int lane = tid_fresh() & 63, gw = blockIdx.x * 8 + (tid_fresh() >> 6), nw = gridDim.x * 8;
  const int dv = (lane & 15) * 16;
  f32x4 gg[4];
#pragma unroll
  for (int i = 0; i < 4; ++i) gg[i] = *(const f32x4*)(p.gla_g + dv + i * 4);
  for (int r0 = gw * 4; r0 < CMAX; r0 += nw * 4) {
    u32x4 a0[4], a1[4], b0[4], b1[4], g0[4], g1[4];
#pragma unroll
    for (int j = 0; j < 4; ++j) { const int r = r0 + j; const int prow = (r / ck.S) * ck.Lp + 64 + (r % ck.S);
      const bf16_t* a = p.Of + (size_t)r * 1024 + lane * 16; const bf16_t* b = p.Ob + (size_t)r * 1024 + lane * 16;
      const bf16_t* gr = p.proj + (size_t)prow * NPROJ + C_GR + lane * 16;
      a0[j] = *(const u32x4*)a; a1[j] = *(const u32x4*)(a + 8); b0[j] = *(const u32x4*)b; b1[j] = *(const u32x4*)(b + 8); g0[j] = *(const u32x4*)gr; g1[j] = *(const u32x4*)(gr + 8); }
#pragma unroll
    for (int j = 0; j < 4; ++j) {
      f32x4 v[4]; float s = 0;
#pragma unroll
      for (int i = 0; i < 4; ++i) { const u32x4& au = i < 2 ? a0[j] : a1[j]; const u32x4& bu = i < 2 ? b0[j] : b1[j]; const int w = (i & 1) * 2;
        v[i][0] = bflo(au[w]) + bflo(bu[w]); v[i][1] = bfhi(au[w]) + bfhi(bu[w]); v[i][2] = bflo(au[w + 1]) + bflo(bu[w + 1]); v[i][3] = bfhi(au[w + 1]) + bfhi(bu[w + 1]);
        s += v[i][0] * v[i][0] + v[i][1] * v[i][1] + v[i][2] * v[i][2] + v[i][3] * v[i][3]; }
      s += shfl_xor_l(s, 1, lane); s += shfl_xor_l(s, 2, lane); s += shfl_xor_l(s, 4, lane); s += shfl_xor_l(s, 8, lane);
      const float rs = rsqrtf(s * (1.f / 256.f) + opaque_f(1e-6f));
      f32x4 y[4];
#pragma unroll
      for (int i = 0; i < 4; ++i) { const u32x4& gu = i < 2 ? g0[j] : g1[j]; const int w = (i & 1) * 2;
        y[i][0] = v[i][0] * rs * gg[i][0] * siluf_(bflo(gu[w])); y[i][1] = v[i][1] * rs * gg[i][1] * siluf_(bfhi(gu[w]));
        y[i][2] = v[i][2] * rs * gg[i][2] * siluf_(bflo(gu[w + 1])); y[i][3] = v[i][3] * rs * gg[i][3] * siluf_(bfhi(gu[w + 1])); }
      bf16_t* d = p.Acat + (size_t)(r0 + j) * 2048 + lane * 16;
      *(u32x4*)d = pack8(y[0], y[1]); *(u32x4*)(d + 8) = pack8(y[2], y[3]);
    }
  }
}

#define XB_XCNT(j)  (256  + 64 * (j))
#define XB_XSUB(j)  (1280 + 64 * (j))
#define XB_XGEN(j)  (2304 + 64 * (j))
#define XB_TOP      3328
#define XB_TOPGEN   3392
#define XCD_BAR_WORDS 3456
#define BAR_TOTAL_WORDS (3456 + 192)
#define XB_SPIN_CAP (1u << 20)
__device__ __forceinline__ unsigned xb_ld(unsigned* p) { return __hip_atomic_load(p, __ATOMIC_RELAXED, __HIP_MEMORY_SCOPE_AGENT); }
__device__ __forceinline__ unsigned xb_add(unsigned* p, unsigned v) { return __hip_atomic_fetch_add(p, v, __ATOMIC_RELAXED, __HIP_MEMORY_SCOPE_AGENT); }
__device__ __forceinline__ unsigned xb_xcc_id() { return (unsigned)__builtin_amdgcn_s_getreg((3 << 11) | 20) & 0xFu; }
#define XB_SPIN(cond, bar) do { unsigned _sp = 0; while (cond) { __builtin_amdgcn_s_sleep(1); \
    if ((++_sp & 255u) == 0u) { if (xb_ld(&(bar)[XB_TMO])) break; if (_sp > XB_SPIN_CAP) { atomicAdd(&(bar)[XB_TMO], 1u); break; } } } } while (0)
__device__ __forceinline__ void xcd_barrier_complete(unsigned* bar, unsigned x, unsigned& nloc, unsigned& nx) {
  const unsigned G = gridDim.x;
  unsigned sum, cnt, mine, sp = 0u;
  for (;;) {
    sum = 0u; cnt = 0u; mine = 0u;
#pragma unroll
    for (unsigned j = 0; j < 16; ++j) { const unsigned c = xb_ld(&bar[XB_XCNT(j)]); sum += c; cnt += (c > 0u) ? 1u : 0u; mine = (j == x) ? c : mine; }
    if (sum == G) break;
    __builtin_amdgcn_s_sleep(1);
    if ((++sp & 255u) == 0u) { if (xb_ld(&bar[XB_TMO])) break; if (sp > XB_SPIN_CAP) { atomicAdd(&bar[XB_TMO], 1u); break; } }
  }
  nloc = mine > 0u ? mine : 1u; nx = cnt > 0u ? cnt : 1u;
}
__device__ __forceinline__ void xcd_barrier(unsigned* bar, volatile LAS unsigned* st) {
  asm volatile("s_waitcnt vmcnt(0)" ::: "memory");
  __syncthreads();
  if (tid_fresh() == 0) {
    const unsigned x = xb_xcc_id();
    __builtin_amdgcn_s_waitcnt(0);
    unsigned nloc = st[0], nx = st[1];
    if (nloc == 0u) { xcd_barrier_complete(bar, x, nloc, nx); st[0] = nloc; st[1] = nx; }
    const unsigned old = xb_add(&bar[XB_XSUB(x)], 1u);
    const unsigned gen = old / nloc;
    if (old + 1u == (gen + 1u) * nloc) {
      __builtin_amdgcn_fence(__ATOMIC_RELEASE, "agent");
      asm volatile("s_waitcnt vmcnt(0)" ::: "memory");
      const unsigned og = xb_add(&bar[XB_TOP], 1u);
      const unsigned tg = og / nx;
      if (og + 1u == (tg + 1u) * nx) xb_add(&bar[XB_TOPGEN], 1u);
      else XB_SPIN(xb_ld(&bar[XB_TOPGEN]) == tg, bar);
      __builtin_amdgcn_fence(__ATOMIC_ACQUIRE, "agent");
      xb_add(&bar[XB_XGEN(x)], 1u);
      asm volatile("s_waitcnt vmcnt(0)" ::: "memory");
    } else {
      XB_SPIN(xb_ld(&bar[XB_XGEN(x)]) == gen, bar);
      __builtin_amdgcn_fence(__ATOMIC_ACQUIRE, "agent");
      asm volatile("s_waitcnt vmcnt(0)" ::: "memory");
    }
  }
  __syncthreads();
}

#define REP_G1 1
#define REP_SYNC 1
#define REP_PREP 1
#define REP_STATS 1
#define REP_G23 1
#define REP_GLA 1
#define REP_ATT 1
#define REP_COMB 1
#define REP_G45 1
#define REP_G6 1
__device__ __forceinline__ int sfresh(int v) { asm volatile("" : "+s"(v)); return v; }
#define PHASE_VARS const Params p = load_params(); const int cc = c, G = sfresh((int)gridDim.x), bid = sfresh((int)blockIdx.x); const Chunk ck = get_chunk(p, cc);
__global__ void __launch_bounds__(512, 2) fwd_megakernel(Params p_arg) {
  extern __shared__ __attribute__((aligned(16))) char shm[];
  cg::grid_group grid = cg::this_grid();
  LAS unsigned char* lds3 = (LAS unsigned char*)shm;
  volatile LAS unsigned* xst = (volatile LAS unsigned*)(lds3 + 131072);
  if ((threadIdx.x & 63) == 0) *(volatile int*)(shm + WIDX_LDS_OFF + hw_slot() * 4) = (int)(threadIdx.x >> 6);
  { const Params p = load_params(); unsigned* bar0 = p.bar; if (threadIdx.x == 0) { xst[0] = 0u; xst[1] = 0u; (void)xb_add(&bar0[XB_XCNT(xb_xcc_id())], 1u); } }
  __syncthreads();

  for (int rep = 0; rep < REP_PREP; ++rep) { const Params p = load_params(); prep_phase(p, shm); }
  { const Params p = load_params(); ln_h_phase(p, 0, p.hbf0); }
  { const Params p = load_params(); if (p.bar == nullptr) grid.sync(); xcd_barrier(p.bar, xst); }

#pragma unroll
  for (int c = 0; c < 3; ++c) {
    for (int rep = 0; rep < REP_G1; ++rep)
    { PHASE_VARS bf16_t* hb = (cc & 1) ? p.hbf1 : p.hbf0;
      pg8::Gemm g{hb, p.W1t, 1024, 1024, 1024, ck.nPp, 27, 0, 0}; pg8::StaticOrder S; S.init(g.nM, g.nN, G, bid);
      Epi1 E{p.proj, p.cosT, p.sinT, ck.Lp}; pg8::gemm_phase(lds3, g, S, E); }
    for (int rs = 0; rs < REP_SYNC; ++rs) { const Params p = load_params(); xcd_barrier(p.bar, xst); }
    for (int rep = 0; rep < REP_STATS; ++rep)
    { PHASE_VARS stats_phase(p, ck, shm); }
    for (int rs = 0; rs < REP_SYNC; ++rs) { const Params p = load_params(); xcd_barrier(p.bar, xst); }
    for (int rep = 0; rep < REP_G23; ++rep) {
    { PHASE_VARS
      pg8::Gemm g{p.proj + C_CQ, p.Wqt, NPROJ, 384, 384, 64, 6, ck.S, ck.Lp}; pg8::StaticOrder S; S.init(g.nM, g.nN, G, bid);
      Epi2 E{p.qbuf, p.rstdq, p.cosT, p.sinT, ck.S, ck.Lp}; pg8::gemm_phase(lds3, g, S, E); }
    { PHASE_VARS
      pg8::Gemm g{p.proj + C_CKV, p.Wkvt, NPROJ, 256, 256, ck.nPp, 8, 0, 0}; pg8::StaticOrder S; S.init(g.nM, g.nN, G, (bid + 128) % G);
      Epi3 E{p.kvbuf, p.rstdkv}; pg8::gemm_phase(lds3, g, S, E); }
    }
    for (int rs = 0; rs < REP_SYNC; ++rs) { const Params p = load_params(); xcd_barrier(p.bar, xst); }
    { PHASE_VARS
      const int xcd = bid & 7, li = bid >> 3;
      const int ngrp = ck.nseq * 8, grp = xcd + 8 * (li >> 2);
      const bool has_gla = (G == 256) ? (grp < ngrp) : (bid < ck.nseq * 32);
      for (int rep = 0; rep < REP_GLA; ++rep) {
        if (G == 256) { if (has_gla) gla::item(p, ck, grp * 4 + (li & 3), shm); }
        else for (int it = bid; it < ck.nseq * 32; it += G) gla::item(p, ck, it, shm);
      }
      const int qb = ck.S / 256, nunits = ck.nseq * qb * 8, NT = ck.Lp / 64;
      for (int rep = 0; rep < REP_ATT; ++rep) {
        if (G == 256) {
          int v0, nv, vstep;
          if (cc < 2) { v0 = li; nv = 2; vstep = 32; }
          else if (li < 16) { v0 = 48 + li; nv = 1; vstep = 0; }
          else { v0 = li - 16; nv = 3; vstep = 16; }
          for (int k = 0; k < nv; ++k) {
            const int v = v0 + k * vstep, head = xcd, seq = v / qb, blk = v % qb;
            const int crow = seq * ck.S + blk * 256; const size_t prow_seq = (size_t)seq * ck.Lp, prow_q = prow_seq + 64 + blk * 256;
            att::attn_unit(p.qbuf + (size_t)crow * 1536 + head * 192, p.kvbuf + prow_seq * 2048 + head * 256, p.kvbuf + prow_seq * 2048 + head * 256 + 128,
                           p.proj + prow_seq * NPROJ + C_KR, p.proj + prow_q * NPROJ + C_MZ + head * 128, p.Acat + (size_t)crow * 2048 + 1024 + head * 128, NT, shm, lds3);
          }
        } else {
          for (int u = bid; u < nunits; u += G) {
            const int blk = u % qb, head = (u / qb) & 7, seq = u / (qb * 8);
            const int crow = seq * ck.S + blk * 256; const size_t prow_seq = (size_t)seq * ck.Lp, prow_q = prow_seq + 64 + blk * 256;
            att::attn_unit(p.qbuf + (size_t)crow * 1536 + head * 192, p.kvbuf + prow_seq * 2048 + head * 256, p.kvbuf + prow_seq * 2048 + head * 256 + 128,
                           p.proj + prow_seq * NPROJ + C_KR, p.proj + prow_q * NPROJ + C_MZ + head * 128, p.Acat + (size_t)crow * 2048 + 1024 + head * 128, NT, shm, lds3);
          }
        }
      }
      __syncthreads(); }
    for (int rs = 0; rs < REP_SYNC; ++rs) { const Params p = load_params(); xcd_barrier(p.bar, xst); }
    for (int rep = 0; rep < REP_COMB; ++rep)
    { PHASE_VARS combine_phase(p, ck); }
    if (c + 1 < 3) { const Params p = load_params(); ln_h_phase(p, c + 1, ((c + 1) & 1) ? p.hbf1 : p.hbf0); }
    for (int rs = 0; rs < REP_SYNC; ++rs) { const Params p = load_params(); xcd_barrier(p.bar, xst); }
    for (int rep = 0; rep < REP_G45; ++rep) {
    { PHASE_VARS
      pg8::Gemm g{p.Acat, p.Wcat, 2048, 2048, 2048, 64, 4, 0, 0}; pg8::StaticOrder S; S.init(g.nM, g.nN, G, bid);
      Epi45D E{p.mix, p.proj, p.b_merge, ck.S, ck.Lp}; pg8::gemm_phase(lds3, g, S, E); }
    }
    for (int rs = 0; rs < REP_SYNC; ++rs) { const Params p = load_params(); xcd_barrier(p.bar, xst); }
    { PHASE_VARS
      pg8::Gemm g{p.mix, p.Woutt, 1024, 1024, 1024, 64, 4, 0, 0}; pg8::StaticOrder S; S.init(g.nM, g.nN, G, bid);
      Epi6Ln E{cc};
      pg8::gemm_phase(lds3, g, S, E); }
  }
}

extern "C" void kernel_launch(void* const* d_in, const int* in_sizes, int n_in, void* d_out, int out_size, void* d_ws, size_t ws_size, hipStream_t stream) {
  Params p{};
  p.x_prompt = (const float*)d_in[0]; p.x_sample = (const float*)d_in[1]; p.meta = (const float*)d_in[2]; p.emb_g = (const float*)d_in[3]; p.emb_b = (const float*)d_in[4];
  p.w_in = (const float*)d_in[5]; p.b_merge = (const float*)d_in[6]; p.wgf = (const float*)d_in[7]; p.bgf = (const float*)d_in[8]; p.wgb = (const float*)d_in[9]; p.bgb = (const float*)d_in[10];
  p.gla_g = (const float*)d_in[11]; p.w_o_gla = (const float*)d_in[12]; p.q_g = (const float*)d_in[13]; p.w_q_b = (const float*)d_in[14]; p.kv_g = (const float*)d_in[15]; p.w_kv_b = (const float*)d_in[16];
  p.w_o_mla = (const float*)d_in[17]; p.w_out = (const float*)d_in[18]; p.pln_g = (const float*)d_in[19]; p.pln_b = (const float*)d_in[20];
  p.out = (float*)d_out;
  char* w = (char*)d_ws; size_t off = 0;
  auto take = [&](size_t bytes) { char* r = w + off; off += (bytes + 255) & ~(size_t)255; return r; };
  p.bar = (unsigned*)take((size_t)BAR_TOTAL_WORDS * 4);
  p.W1t = (bf16_t*)take((size_t)NPROJ * 1024 * 2); p.Wqt = (bf16_t*)take((size_t)1536 * 384 * 2); p.Wkvt = (bf16_t*)take((size_t)2048 * 256 * 2);
  p.Wcat = (bf16_t*)take((size_t)1024 * 2048 * 2); p.Woutt = (bf16_t*)take((size_t)1024 * 1024 * 2);
  p.cosT = (float*)take((size_t)NPOS * 32 * 4); p.sinT = (float*)take((size_t)NPOS * 32 * 4); p.lnstat = (float2*)take((size_t)49152 * 8); p.gst = (float2*)take((size_t)3 * 64 * 4 * 256 * 8);
  p.hbf0 = (bf16_t*)take((size_t)PMAX * 1024 * 2); p.hbf1 = (bf16_t*)take((size_t)PMAX * 1024 * 2);
  p.proj = (bf16_t*)take((size_t)PMAX * NPROJ * 2);
  p.gF = (float*)take((size_t)PMAX * 512 * 4); p.gB = (float*)take((size_t)PMAX * 512 * 4);
  p.rstdq = (float*)take((size_t)PMAX * 4); p.rstdkv = (float*)take((size_t)PMAX * 4);
  p.qbuf = (bf16_t*)take((size_t)CMAX * 1536 * 2); p.kvbuf = (bf16_t*)take((size_t)PMAX * 2048 * 2);
  p.Of = (bf16_t*)take((size_t)CMAX * 1024 * 2); p.Ob = (bf16_t*)take((size_t)CMAX * 1024 * 2);
  p.Acat = (bf16_t*)take((size_t)CMAX * 2048 * 2); p.mix = (bf16_t*)take((size_t)CMAX * 1024 * 2);
  if (off > ws_size) { fprintf(stderr, "kernel_launch: workspace too small: need %zu have %zu\n", off, ws_size); return; }
  static int grid_blocks = 0;
  if (!grid_blocks) {
    if (hipFuncSetAttribute((const void*)fwd_megakernel, hipFuncAttributeMaxDynamicSharedMemorySize, (int)LDS_BYTES) != hipSuccess) { fprintf(stderr, "kernel_launch: LDS attribute failed\n"); return; }
    int dev = 0, cus = 0, per_cu = 0;
    hipGetDevice(&dev);
    hipDeviceGetAttribute(&cus, hipDeviceAttributeMultiprocessorCount, dev);
    hipOccupancyMaxActiveBlocksPerMultiprocessor(&per_cu, fwd_megakernel, 512, LDS_BYTES);
    if (per_cu < 1) { fprintf(stderr, "kernel_launch: occupancy 0\n"); return; }
    if (cus < 256) { fprintf(stderr, "kernel_launch: needs 256 CUs, have %d\n", cus); return; }
    grid_blocks = 256;
  }
  hipMemsetAsync(p.bar, 0, (size_t)BAR_TOTAL_WORDS * 4, stream);
  void* args[] = {&p};
  hipError_t e = hipLaunchCooperativeKernel((void*)fwd_megakernel, dim3(grid_blocks), dim3(512), args, LDS_BYTES, stream);
  if (e != hipSuccess) fprintf(stderr, "cooperative launch failed: %s (grid %d)\n", hipGetErrorString(e), grid_blocks);
}
```

```cpp
#include <hip/hip_runtime.h>
#include <hip/hip_cooperative_groups.h>
#include <cstdio>
#include <cstdint>
namespace cg = cooperative_groups;

typedef unsigned short bf16_t;
typedef short bf16x8 __attribute__((ext_vector_type(8)));
typedef short s16x4 __attribute__((ext_vector_type(4)));
typedef float f32x4 __attribute__((ext_vector_type(4)));
typedef float f32x16 __attribute__((ext_vector_type(16)));
typedef unsigned u32x4 __attribute__((ext_vector_type(4)));
#define LAS __attribute__((address_space(3)))

#define XB_TMO 128
#define LN_CNT_WORD 3456
constexpr int DM = 1024;
constexpr int NPROJ = 6912;
constexpr int C_GQ = 0, C_GK = 512, C_GV = 1024, C_GR = 2048, C_MZ = 3072, C_MA = 4096, C_MB = 5120, C_CQ = 6144, C_CKV = 6528, C_KR = 6784, C_GLF = 6848, C_GLB = 6864;
constexpr int PMAX = 16896, CMAX = 16384;
constexpr int NPOS = 4112;
constexpr size_t LDS_BYTES = 135168;

struct Chunk { int nseq, S, Lp, nPp, crow0; const float* x; };

struct Params {
  const float *x_prompt, *x_sample, *meta, *emb_g, *emb_b, *w_in, *b_merge, *wgf, *bgf, *wgb, *bgb, *gla_g, *w_o_gla, *q_g, *w_q_b, *kv_g, *w_kv_b, *w_o_mla, *w_out, *pln_g, *pln_b;
  float* out; unsigned* bar;
  bf16_t *W1t, *Wqt, *Wkvt, *Wcat, *Woutt;
  float *cosT, *sinT; float2* lnstat; float2* gst;
  bf16_t *hbf0, *hbf1, *proj; float *gF, *gB, *rstdq, *rstdkv; bf16_t *qbuf, *kvbuf; bf16_t *Of, *Ob; bf16_t *Acat, *mix;
};

__device__ __forceinline__ Chunk get_chunk(const Params& p, int c) {
  Chunk k;
  if (c < 2) { k.nseq = 8; k.S = 2048; k.Lp = 2112; k.nPp = 66; k.crow0 = c * 16384; k.x = p.x_prompt + (size_t)c * 16384 * DM; }
  else { k.nseq = 4; k.S = 4096; k.Lp = 4160; k.nPp = 65; k.crow0 = 32768; k.x = p.x_sample; }
  return k;
}


typedef const __attribute__((address_space(4))) Params* PP;
__device__ __forceinline__ Params load_params() {
  unsigned long v = (unsigned long)__builtin_amdgcn_kernarg_segment_ptr();
  asm volatile("" : "+s"(v));
  Params p; __builtin_memcpy(&p, (PP)v, sizeof(Params)); return p;
}

#define WIDX_LDS_OFF (131072 + 64)
__device__ __forceinline__ int hw_slot() { return (int)__builtin_amdgcn_s_getreg((5 << 11) | 4) & 63; }
__device__ __forceinline__ int tid_fresh() {
  extern __shared__ __attribute__((aligned(16))) char shm_tid[];
  const int key = hw_slot();
  int w = *(volatile LAS int*)((LAS char*)shm_tid + WIDX_LDS_OFF + key * 4);
  w = __builtin_amdgcn_readfirstlane(w);
  unsigned z = 0u; asm volatile("" : "+v"(z));
  int t = w * 64 + (int)__builtin_amdgcn_mbcnt_hi(~0u, __builtin_amdgcn_mbcnt_lo(~0u, z));
  asm volatile("" : "+v"(t)); return t;
}
__device__ __forceinline__ unsigned cvt_pk_bf16(float lo, float hi) { unsigned r; asm volatile("v_cvt_pk_bf16_f32 %0, %1, %2" : "=v"(r) : "v"(lo), "v"(hi)); return r; }
__device__ __forceinline__ bf16_t f2bf(float f) { return (bf16_t)(cvt_pk_bf16(f, 0.f) & 0xffffu); }
__device__ __forceinline__ float bflo(unsigned u) { return __uint_as_float(u << 16); }
__device__ __forceinline__ float bfhi(unsigned u) { return __uint_as_float(u & 0xffff0000u); }
__device__ __forceinline__ float bf2f(bf16_t b) { return __uint_as_float(((unsigned)b) << 16); }
__device__ __forceinline__ float shfl_xor_l(float v, int mask, int lane) { return __int_as_float(__builtin_amdgcn_ds_bpermute((lane ^ mask) << 2, __float_as_int(v))); }
__device__ __forceinline__ float wave_sum(float v, int lane) {
#pragma unroll
  for (int o = 32; o > 0; o >>= 1) v += shfl_xor_l(v, o, lane);
  return v;
}
__device__ __forceinline__ float opaque_f(float c) { asm volatile("" : "+s"(c)); return c; }
__device__ __forceinline__ float sigmoidf_(float x) { return __builtin_amdgcn_rcpf(1.f + __expf(-x)); }
__device__ __forceinline__ float siluf_(float x) { return x * __builtin_amdgcn_rcpf(1.f + __expf(-x)); }
__device__ __forceinline__ float dpp_xor1(float v) { return __int_as_float(__builtin_amdgcn_update_dpp(0, __float_as_int(v), 0xB1, 0xf, 0xf, false)); }
__device__ __forceinline__ float dpp_xor2(float v) { return __int_as_float(__builtin_amdgcn_update_dpp(0, __float_as_int(v), 0x4E, 0xf, 0xf, false)); }
__device__ __forceinline__ float dpp_hmirror(float v) { return __int_as_float(__builtin_amdgcn_update_dpp(0, __float_as_int(v), 0x141, 0xf, 0xf, false)); }
__device__ __forceinline__ float dpp_mirror(float v) { return __int_as_float(__builtin_amdgcn_update_dpp(0, __float_as_int(v), 0x140, 0xf, 0xf, false)); }

namespace pg8 {
constexpr int BM = 256, BK = 64, HALF = 128, HTB = HALF * BK * 2, STAGE_BYTES = 8 * HTB, NXCD = 8, WGM = 8;
__device__ __forceinline__ int lds_byte(int r, int c) { const int st = (r >> 4) * 2 + (c >> 5), rr = r & 15, cc = c & 31, ob = rr * 64 + cc * 2; return st * 1024 + (ob ^ (((ob >> 9) & 1) << 5)); }
__device__ __forceinline__ void stage_rc(int b, int& R, int& C) { const int st = b / 1024, sb = b % 1024, swz = sb ^ (((sb >> 9) & 1) << 5); R = (st >> 1) * 16 + swz / 64; C = (st & 1) * 32 + (swz % 64) / 2; }
__device__ __forceinline__ int perm32(int rho) { const int n = rho >> 4, i = rho & 15; return 8 * (i >> 2) + 4 * n + (i & 3); }

struct Unit { int pm, pn; };
struct Gemm { const bf16_t* A; const bf16_t* Bt; int lda, ldb, K, nM, nN, mapS, mapLp; };

struct StaticOrder {
  int nM, nN, nwg, G, c;
  __device__ void init(int nM_, int nN_, int G_, int c_) { nM = nM_; nN = nN_; nwg = nM * nN; G = G_; c = c_; }
  __device__ bool next(int i, Unit& u) const {
    const long L = (long)i * G + c; if (L >= nwg) return false;
    int wgid = (int)L; { const int q = nwg / NXCD, r = nwg % NXCD, xcd = wgid % NXCD, off = wgid / NXCD; wgid = (xcd < r ? xcd * (q + 1) : r * (q + 1) + (xcd - r) * q) + off; }
    const int nig = WGM * nN, gid = wgid / nig, fm = gid * WGM, gsz = (nM - fm) < WGM ? (nM - fm) : WGM;
    u.pm = fm + ((wgid % nig) % gsz); u.pn = (wgid % nig) / gsz; return true;
  }
};
__device__ __forceinline__ size_t arow(const Gemm& g, int pm) {
  if (g.mapS == 0) return (size_t)pm * BM;
  const int rc = pm * BM; return (size_t)(rc / g.mapS) * g.mapLp + 64 + (rc % g.mapS);
}

template <class Epi>
__device__ __forceinline__ void gemm_phase(LAS unsigned char* lds, const Gemm g, const StaticOrder& S, const Epi& E) {
  const int tid = tid_fresh(), wid = __builtin_amdgcn_readfirstlane(tid >> 6), lane = tid & 63, wr = wid >> 2, wc = wid & 3, fr = lane & 15, fq = lane >> 4;
  const int K = g.K, nt = K / BK;
  unsigned voffA[2], voffB[2];
#pragma unroll
  for (int i = 0; i < 2; ++i) { int R, C; stage_rc(tid * 16 + i * 8192, R, C); const int Rb = Epi::PERM ? ((R & ~31) + perm32(R & 31)) : R;
    voffA[i] = (unsigned)(R * g.lda + C) * 2u; voffB[i] = (unsigned)(Rb * g.ldb + C) * 2u; }
  const size_t kstep = (size_t)(BK * 2);
  const size_t hstepA = (size_t)HALF * g.lda * 2, hstepB = (size_t)HALF * g.ldb * 2;
  const unsigned ldsw = (unsigned)wid * 1024u;
  const int aoff = lds_byte(wr * 64 + fr, fq * 8), boff = lds_byte(wc * 32 + fr, fq * 8);
#define PG8_SA(b, h) (((b) * 2 + (h)) * HTB)
#define PG8_SB(b, h) ((4 + (b) * 2 + (h)) * HTB)
#define PG8_STAGE(bufoff, gbase, voff) do { _Pragma("unroll") for (int _i = 0; _i < 2; ++_i) \
    __builtin_amdgcn_global_load_lds((const unsigned*)((const char*)(gbase) + (voff)[_i]), (LAS unsigned*)(lds + (bufoff) + ldsw + _i * 8192), 16, 0, 0); } while (0)
#define PG8_LDA(dst, b, h) do { _Pragma("unroll") for (int m = 0; m < 4; ++m) _Pragma("unroll") for (int k = 0; k < 2; ++k) dst[m][k] = *(const LAS bf16x8*)(lds + PG8_SA(b, h) + aoff + m * 2048 + k * 1024); } while (0)
#define PG8_LDB(dst, b, h) do { _Pragma("unroll") for (int n = 0; n < 2; ++n) _Pragma("unroll") for (int k = 0; k < 2; ++k) dst[n][k] = *(const LAS bf16x8*)(lds + PG8_SB(b, h) + boff + n * 2048 + k * 1024); } while (0)
#define PG8_MMA(ai, bj, At, Bt) do { __builtin_amdgcn_s_setprio(1); _Pragma("unroll") for (int m = 0; m < 4; ++m) _Pragma("unroll") for (int n = 0; n < 2; ++n) _Pragma("unroll") for (int k = 0; k < 2; ++k) \
    acc[ai][bj][m][n] = __builtin_amdgcn_mfma_f32_16x16x32_bf16(Bt[n][k], At[m][k], acc[ai][bj][m][n], 0, 0, 0); __builtin_amdgcn_s_setprio(0); } while (0)
#define PG8_WAIT_V(n) asm volatile("s_waitcnt vmcnt(" #n ")" ::: "memory")
#define PG8_WAIT_L(n) asm volatile("s_waitcnt lgkmcnt(" #n ")" ::: "memory")
#define PG8_BAR __builtin_amdgcn_s_barrier()
#define PG8_SCHED __builtin_amdgcn_sched_barrier(0)
  Unit cur, nxt; int ui = 0;
  if (!S.next(0, cur)) return;
  f32x4 acc[2][2][4][2];
#pragma unroll
  for (int a = 0; a < 2; ++a)
#pragma unroll
    for (int b = 0; b < 2; ++b)
#pragma unroll
      for (int m = 0; m < 4; ++m)
#pragma unroll
        for (int n = 0; n < 2; ++n) acc[a][b][m][n] = (f32x4){0.f, 0.f, 0.f, 0.f};
  bf16x8 At[4][2], B0[2][2], B1[2][2];
  const char* cA = (const char*)g.A + arow(g, cur.pm) * g.lda * 2; const char* cB = (const char*)g.Bt + (size_t)cur.pn * BM * g.ldb * 2;
  PG8_STAGE(PG8_SB(0, 0), cB, voffB); PG8_STAGE(PG8_SA(0, 0), cA, voffA); PG8_STAGE(PG8_SB(0, 1), cB + hstepB, voffB); PG8_STAGE(PG8_SA(0, 1), cA + hstepA, voffA);
  if (wr == 1) PG8_BAR;
  PG8_WAIT_V(4); PG8_BAR;
  PG8_STAGE(PG8_SB(1, 0), cB + kstep, voffB); PG8_STAGE(PG8_SA(1, 0), cA + kstep, voffA); PG8_STAGE(PG8_SB(1, 1), cB + hstepB + kstep, voffB);
  PG8_WAIT_V(6); PG8_BAR;
  for (;;) {
    const bool has_next = S.next(ui + 1, nxt);
    const char* nA = has_next ? (const char*)g.A + arow(g, nxt.pm) * g.lda * 2 : cA; const char* nB = has_next ? (const char*)g.Bt + (size_t)nxt.pn * BM * g.ldb * 2 : cB;
#pragma unroll 1
    for (int t = 0; t < nt; t += 2) {
      if constexpr (Epi::DUAL) { if (t == (nt >> 1)) E.mid(acc, cur, wr, wc, fr, fq); }
      const bool last = (t == nt - 2);
      const char* a1 = cA + (size_t)(t + 1) * kstep;
      const char* a2 = last ? nA : cA + (size_t)(t + 2) * kstep; const char* b2 = last ? nB : cB + (size_t)(t + 2) * kstep;
      const char* a3 = a2 + kstep; const char* b3 = b2 + kstep;
      PG8_LDB(B0, 0, 0); PG8_SCHED; PG8_LDA(At, 0, 0); PG8_STAGE(PG8_SA(1, 1), a1 + hstepA, voffA);
      PG8_WAIT_L(8); PG8_BAR; PG8_WAIT_L(0); PG8_MMA(0, 0, At, B0); PG8_BAR; PG8_SCHED;
      PG8_LDB(B1, 0, 1); PG8_STAGE(PG8_SB(0, 0), b2, voffB);
      PG8_BAR; PG8_WAIT_L(0); PG8_MMA(0, 1, At, B1); PG8_BAR;
      PG8_LDA(At, 0, 1); PG8_STAGE(PG8_SA(0, 0), a2, voffA);
      PG8_BAR; PG8_WAIT_L(0); PG8_MMA(1, 0, At, B0); PG8_BAR; PG8_SCHED;
      PG8_STAGE(PG8_SB(0, 1), b2 + hstepB, voffB);
      PG8_WAIT_V(6); PG8_BAR; PG8_MMA(1, 1, At, B1); PG8_BAR;
      PG8_LDB(B0, 1, 0); PG8_SCHED; PG8_LDA(At, 1, 0); PG8_STAGE(PG8_SA(0, 1), a2 + hstepA, voffA);
      PG8_WAIT_L(8); PG8_BAR; PG8_WAIT_L(0); PG8_MMA(0, 0, At, B0); PG8_BAR; PG8_SCHED;
      PG8_LDB(B1, 1, 1); PG8_STAGE(PG8_SB(1, 0), b3, voffB);
      PG8_BAR; PG8_WAIT_L(0); PG8_MMA(0, 1, At, B1); PG8_BAR;
      PG8_LDA(At, 1, 1); PG8_STAGE(PG8_SA(1, 0), a3, voffA);
      PG8_BAR; PG8_WAIT_L(0); PG8_MMA(1, 0, At, B0); PG8_BAR; PG8_SCHED;
      PG8_STAGE(PG8_SB(1, 1), b3 + hstepB, voffB);
      PG8_WAIT_V(6); PG8_BAR; PG8_MMA(1, 1, At, B1); PG8_BAR;
    }
    if constexpr (!Epi::AFTER_DRAIN) E(acc, cur, wr, wc, fr, fq);
    if (!has_next) break;
#pragma unroll
    for (int a = 0; a < 2; ++a)
#pragma unroll
      for (int b = 0; b < 2; ++b)
#pragma unroll
        for (int m = 0; m < 4; ++m)
#pragma unroll
          for (int n = 0; n < 2; ++n) acc[a][b][m][n] = (f32x4){0.f, 0.f, 0.f, 0.f};
    cur = nxt; cA = nA; cB = nB; ++ui;
  }
  PG8_WAIT_V(0);
  if (wr == 0) PG8_BAR;
  PG8_BAR;
  if constexpr (Epi::AFTER_DRAIN) E.fused(acc, cur, wr, wc, fr, fq, (char*)lds);
#undef PG8_SA
#undef PG8_SB
#undef PG8_STAGE
#undef PG8_LDA
#undef PG8_LDB
#undef PG8_MMA
#undef PG8_WAIT_V
#undef PG8_WAIT_L
#undef PG8_BAR
#undef PG8_SCHED
}
}
using pg8::Unit;

__device__ __forceinline__ u32x4 pack8(f32x4 a, f32x4 b) { return (u32x4){cvt_pk_bf16(a[0], a[1]), cvt_pk_bf16(a[2], a[3]), cvt_pk_bf16(b[0], b[1]), cvt_pk_bf16(b[2], b[3])}; }
__device__ __forceinline__ void rope8(f32x4& a, f32x4& b, const float* cosT, const float* sinT, int pos, int i0) {
  const f32x4 c = *(const f32x4*)(cosT + pos * 32 + i0), s = *(const f32x4*)(sinT + pos * 32 + i0);
  f32x4 oa, ob;
  oa[0] = a[0] * c[0] - a[1] * s[0]; oa[1] = a[0] * s[0] + a[1] * c[0];
  oa[2] = a[2] * c[1] - a[3] * s[1]; oa[3] = a[2] * s[1] + a[3] * c[1];
  ob[0] = b[0] * c[2] - b[1] * s[2]; ob[1] = b[0] * s[2] + b[1] * c[2];
  ob[2] = b[2] * c[3] - b[3] * s[3]; ob[3] = b[2] * s[3] + b[3] * c[3];
  a = oa; b = ob;
}

struct Epi1 {
  static constexpr bool PERM = true, AFTER_DRAIN = false, DUAL = false;
  bf16_t* proj; const float* cosT; const float* sinT; int Lp;
  __device__ __forceinline__ void operator()(const f32x4 (&acc)[2][2][4][2], const Unit& u, int wr, int wc, int fr, int fq) const {
    const int row0 = u.pm * 256 + wr * 64 + fr, colt = u.pn * 256 + wc * 32 + 8 * fq;
#pragma unroll
    for (int ai = 0; ai < 2; ++ai)
#pragma unroll
      for (int m = 0; m < 4; ++m) {
        const int row = row0 + ai * 128 + m * 16;
        bf16_t* rowp = proj + (size_t)row * NPROJ;
#pragma unroll
        for (int bj = 0; bj < 2; ++bj) {
          const int col0 = colt + bj * 128;
          f32x4 v0 = acc[ai][bj][m][0], v1 = acc[ai][bj][m][1];
          if (u.pn == 26 && col0 >= C_KR && col0 < C_KR + 64) {
            int t = row % Lp - 48; if (t < 0) t = 0;
            rope8(v0, v1, cosT, sinT, t, (col0 - C_KR) >> 1);
          }
          *(u32x4*)(rowp + col0) = pack8(v0, v1);
        }
      }
  }
};
struct Epi2 {
  static constexpr bool PERM = true, AFTER_DRAIN = false, DUAL = false;
  bf16_t* q; const float* rstdq; const float* cosT; const float* sinT; int S, Lp;
  __device__ __forceinline__ void operator()(const f32x4 (&acc)[2][2][4][2], const Unit& u, int wr, int wc, int fr, int fq) const {
    const int row0 = u.pm * 256 + wr * 64 + fr, colt = u.pn * 256 + wc * 32 + 8 * fq;
    float rsv[8]; int posv[8];
#pragma unroll
    for (int i = 0; i < 8; ++i) { const int row = row0 + (i >> 2) * 128 + (i & 3) * 16; const int s = row % S; posv[i] = 16 + s; rsv[i] = rstdq[(row / S) * Lp + 64 + s]; }
#pragma unroll
    for (int bj = 0; bj < 2; ++bj) {
      const int col0 = colt + bj * 128, j = col0 % 192;
      if (j >= 128) {
        const int i0 = (j - 128) >> 1;
        f32x4 cv[8], sv[8];
#pragma unroll
        for (int i = 0; i < 8; ++i) { cv[i] = *(const f32x4*)(cosT + posv[i] * 32 + i0); sv[i] = *(const f32x4*)(sinT + posv[i] * 32 + i0); }
#pragma unroll
        for (int i = 0; i < 8; ++i) { const int ai = i >> 2, m = i & 3, row = row0 + ai * 128 + m * 16;
          const f32x4 a = acc[ai][bj][m][0] * rsv[i], b = acc[ai][bj][m][1] * rsv[i]; const f32x4 c = cv[i], sn = sv[i];
          f32x4 oa, ob;
          oa[0] = a[0] * c[0] - a[1] * sn[0]; oa[1] = a[0] * sn[0] + a[1] * c[0]; oa[2] = a[2] * c[1] - a[3] * sn[1]; oa[3] = a[2] * sn[1] + a[3] * c[1];
          ob[0] = b[0] * c[2] - b[1] * sn[2]; ob[1] = b[0] * sn[2] + b[1] * c[2]; ob[2] = b[2] * c[3] - b[3] * sn[3]; ob[3] = b[2] * sn[3] + b[3] * c[3];
          *(u32x4*)(q + (size_t)row * 1536 + col0) = pack8(oa, ob); }
      } else {
#pragma unroll
        for (int i = 0; i < 8; ++i) { const int ai = i >> 2, m = i & 3, row = row0 + ai * 128 + m * 16;
          *(u32x4*)(q + (size_t)row * 1536 + col0) = pack8(acc[ai][bj][m][0] * rsv[i], acc[ai][bj][m][1] * rsv[i]); }
      }
    }
  }
};
struct Epi3 {
  static constexpr bool PERM = true, AFTER_DRAIN = false, DUAL = false;
  bf16_t* kv; const float* rstdkv;
  __device__ __forceinline__ void operator()(const f32x4 (&acc)[2][2][4][2], const Unit& u, int wr, int wc, int fr, int fq) const {
    const int row0 = u.pm * 256 + wr * 64 + fr, colt = u.pn * 256 + wc * 32 + 8 * fq;
    float rsv[8];
#pragma unroll
    for (int i = 0; i < 8; ++i) rsv[i] = rstdkv[row0 + (i >> 2) * 128 + (i & 3) * 16];
#pragma unroll
    for (int ai = 0; ai < 2; ++ai)
#pragma unroll
      for (int m = 0; m < 4; ++m) {
        const int row = row0 + ai * 128 + m * 16;
        const float rs = rsv[ai * 4 + m];
        bf16_t* rowp = kv + (size_t)row * 2048;
#pragma unroll
        for (int bj = 0; bj < 2; ++bj) {
          const int col0 = colt + bj * 128;
          *(u32x4*)(rowp + col0) = pack8(acc[ai][bj][m][0] * rs, acc[ai][bj][m][1] * rs);
        }
      }
  }
};
template <int SECOND> struct Epi45 {
  static constexpr bool PERM = true, AFTER_DRAIN = false, DUAL = false;
  bf16_t* mix; const bf16_t* proj; const float* bm; int S, Lp;
  __device__ __forceinline__ void operator()(const f32x4 (&acc)[2][2][4][2], const Unit& u, int wr, int wc, int fr, int fq) const {
    const int row0 = u.pm * 256 + wr * 64 + fr, colt = u.pn * 256 + wc * 32 + 8 * fq;
#pragma unroll
    for (int ai = 0; ai < 2; ++ai)
#pragma unroll
      for (int m = 0; m < 4; ++m) {
        const int row = row0 + ai * 128 + m * 16;
        const int s = row % S, prow = (row / S) * Lp + 64 + s;
        const bf16_t* gp = proj + (size_t)prow * NPROJ + (SECOND ? C_MB : C_MA);
        bf16_t* rowp = mix + (size_t)row * 1024;
#pragma unroll
        for (int bj = 0; bj < 2; ++bj) {
          const int col0 = colt + bj * 128;
          const u32x4 gv = *(const u32x4*)(gp + col0);
          const f32x4 b0 = *(const f32x4*)(bm + SECOND * 1024 + col0), b1 = *(const f32x4*)(bm + SECOND * 1024 + col0 + 4);
          f32x4 g0, g1;
          g0[0] = sigmoidf_(bflo(gv[0]) + b0[0]); g0[1] = sigmoidf_(bfhi(gv[0]) + b0[1]); g0[2] = sigmoidf_(bflo(gv[1]) + b0[2]); g0[3] = sigmoidf_(bfhi(gv[1]) + b0[3]);
          g1[0] = sigmoidf_(bflo(gv[2]) + b1[0]); g1[1] = sigmoidf_(bfhi(gv[2]) + b1[1]); g1[2] = sigmoidf_(bflo(gv[3]) + b1[2]); g1[3] = sigmoidf_(bfhi(gv[3]) + b1[3]);
          f32x4 v0 = acc[ai][bj][m][0] * g0, v1 = acc[ai][bj][m][1] * g1;
          if (SECOND) {
            const u32x4 old = *(const u32x4*)(rowp + col0);
            v0[0] += bflo(old[0]); v0[1] += bfhi(old[0]); v0[2] += bflo(old[1]); v0[3] += bfhi(old[1]);
            v1[0] += bflo(old[2]); v1[1] += bfhi(old[2]); v1[2] += bflo(old[3]); v1[3] += bfhi(old[3]);
          }
          *(u32x4*)(rowp + col0) = pack8(v0, v1);
        }
      }
  }
};
struct Epi45D {
  static constexpr bool PERM = true, AFTER_DRAIN = false, DUAL = true;
  bf16_t* mix; const bf16_t* proj; const float* bm; int S, Lp;
  template <int FINAL>
  __device__ __forceinline__ void run(f32x4 (&acc)[2][2][4][2], const Unit& u, int wr, int wc, int fr, int fq) const {
    const int row0 = u.pm * 256 + wr * 64 + fr, colt = u.pn * 256 + wc * 32 + 8 * fq;
#pragma unroll
    for (int ai = 0; ai < 2; ++ai) {
      const bf16_t* gp[4];
#pragma unroll
      for (int m = 0; m < 4; ++m) { const int row = row0 + ai * 128 + m * 16; const int s = row % S, prow = (row / S) * Lp + 64 + s; gp[m] = proj + (size_t)prow * NPROJ + colt; }
#pragma unroll
      for (int bj = 0; bj < 2; ++bj) {
        const int col0 = colt + bj * 128;
        u32x4 yv[4], xv[4];
#pragma unroll
        for (int m = 0; m < 4; ++m) { yv[m] = *(const u32x4*)(gp[m] + C_MB + bj * 128); if (!FINAL) xv[m] = *(const u32x4*)(gp[m] + C_MA + bj * 128); }
        const f32x4 c0 = *(const f32x4*)(bm + 1024 + col0), c1 = *(const f32x4*)(bm + 1024 + col0 + 4);
        f32x4 b0 = {}, b1 = {};
        if (!FINAL) { b0 = *(const f32x4*)(bm + col0); b1 = *(const f32x4*)(bm + col0 + 4); }
#pragma unroll
        for (int m = 0; m < 4; ++m) {
          float ey[8];
          ey[0] = 1.f + __expf(-(bflo(yv[m][0]) + c0[0])); ey[1] = 1.f + __expf(-(bfhi(yv[m][0]) + c0[1])); ey[2] = 1.f + __expf(-(bflo(yv[m][1]) + c0[2])); ey[3] = 1.f + __expf(-(bfhi(yv[m][1]) + c0[3]));
          ey[4] = 1.f + __expf(-(bflo(yv[m][2]) + c1[0])); ey[5] = 1.f + __expf(-(bfhi(yv[m][2]) + c1[1])); ey[6] = 1.f + __expf(-(bflo(yv[m][3]) + c1[2])); ey[7] = 1.f + __expf(-(bfhi(yv[m][3]) + c1[3]));
          if (FINAL) {
            f32x4 v0 = acc[ai][bj][m][0], v1 = acc[ai][bj][m][1];
#pragma unroll
            for (int e = 0; e < 4; ++e) { v0[e] *= __builtin_amdgcn_rcpf(ey[e]); v1[e] *= __builtin_amdgcn_rcpf(ey[4 + e]); }
            const int row = row0 + ai * 128 + m * 16;
            *(u32x4*)(mix + (size_t)row * 1024 + col0) = pack8(v0, v1);
          } else {
            float sx[8];
            sx[0] = sigmoidf_(bflo(xv[m][0]) + b0[0]); sx[1] = sigmoidf_(bfhi(xv[m][0]) + b0[1]); sx[2] = sigmoidf_(bflo(xv[m][1]) + b0[2]); sx[3] = sigmoidf_(bfhi(xv[m][1]) + b0[3]);
            sx[4] = sigmoidf_(bflo(xv[m][2]) + b1[0]); sx[5] = sigmoidf_(bfhi(xv[m][2]) + b1[1]); sx[6] = sigmoidf_(bflo(xv[m][3]) + b1[2]); sx[7] = sigmoidf_(bfhi(xv[m][3]) + b1[3]);
#pragma unroll
            for (int e = 0; e < 4; ++e) { acc[ai][bj][m][0][e] *= sx[e] * ey[e]; acc[ai][bj][m][1][e] *= sx[4 + e] * ey[4 + e]; }
          }
        }
      }
    }
  }
  __device__ __forceinline__ void mid(f32x4 (&acc)[2][2][4][2], const Unit& u, int wr, int wc, int fr, int fq) const {
    asm volatile("" : "+v"(fr), "+v"(fq));
    run<0>(acc, u, wr, wc, fr, fq); }
  __device__ __forceinline__ void operator()(f32x4 (&acc)[2][2][4][2], const Unit& u, int wr, int wc, int fr, int fq) const { run<1>(acc, u, wr, wc, fr, fq); }
};
struct Epi6 {
  static constexpr bool PERM = true, AFTER_DRAIN = false, DUAL = false;
  float* out; const float* x; const float2* lnstat; const float* eg; const float* eb;
  __device__ __forceinline__ void operator()(const f32x4 (&acc)[2][2][4][2], const Unit& u, int wr, int wc, int fr, int fq) const {
    const int row0 = u.pm * 256 + wr * 64 + fr, colt = u.pn * 256 + wc * 32 + 8 * fq;
    const float ALPHA = 1.189207115002721f;
#pragma unroll
    for (int ai = 0; ai < 2; ++ai)
#pragma unroll
      for (int m = 0; m < 4; ++m) {
        const int row = row0 + ai * 128 + m * 16;
        const float2 st = lnstat[row];
        const float* xr = x + (size_t)row * 1024; float* orow = out + (size_t)row * 1024;
#pragma unroll
        for (int bj = 0; bj < 2; ++bj) {
          const int col0 = colt + bj * 128;
#pragma unroll
          for (int n = 0; n < 2; ++n) {
            const f32x4 xv = *(const f32x4*)(xr + col0 + 4 * n), gv = *(const f32x4*)(eg + col0 + 4 * n), bv = *(const f32x4*)(eb + col0 + 4 * n);
            f32x4 h = (xv - st.x) * st.y * gv + bv;
            *(f32x4*)(orow + col0 + 4 * n) = ALPHA * h + acc[ai][bj][m][n];
          }
        }
      }
  }
};

struct Epi6Ln {
  static constexpr bool PERM = true, AFTER_DRAIN = true, DUAL = false;
  int cc;
  __device__ __forceinline__ void fused(f32x4 (&acc)[2][2][4][2], const Unit& u, int wr, int wc, int fr, int fq, char* lds) const {
    const Params p = load_params(); const Chunk ck = get_chunk(p, cc);
    float* out = p.out + (size_t)ck.crow0 * DM; const float* x = ck.x; const float2* lnstat = p.lnstat + ck.crow0;
    const float* eg = p.emb_g; const float* eb = p.emb_b; const float* pg = p.pln_g; const float* pb = p.pln_b;
    float2* gst = p.gst + (size_t)cc * 64 * 4 * 256; unsigned* cnt = p.bar + LN_CNT_WORD + cc * 64; unsigned* tmo = p.bar + XB_TMO;
    float* red = (float*)lds; float* rst = red + 2048;
    const int tid = tid_fresh(), colt = u.pn * 256 + wc * 32 + 8 * fq;
    const float ALPHA = 1.189207115002721f;
    f32x4 gvv[4], bvv[4];
#pragma unroll
    for (int j = 0; j < 4; ++j) { const int col = colt + (j >> 1) * 128 + 4 * (j & 1); gvv[j] = *(const f32x4*)(eg + col); bvv[j] = *(const f32x4*)(eb + col); }
#pragma unroll
    for (int ai = 0; ai < 2; ++ai) {
      f32x4 xv[4][4]; float2 st[4];
#pragma unroll
      for (int m = 0; m < 4; ++m) { const int row = u.pm * 256 + wr * 64 + ai * 128 + m * 16 + fr; st[m] = lnstat[row]; const float* xr = x + (size_t)row * 1024;
#pragma unroll
        for (int j = 0; j < 4; ++j) xv[m][j] = *(const f32x4*)(xr + colt + (j >> 1) * 128 + 4 * (j & 1)); }
#pragma unroll
      for (int m = 0; m < 4; ++m) {
        const int lrow = wr * 64 + ai * 128 + m * 16 + fr;
        float s1 = 0.f, s2 = 0.f;
#pragma unroll
        for (int j = 0; j < 4; ++j) { const int bj = j >> 1, n = j & 1;
          const f32x4 z = ALPHA * ((xv[m][j] - st[m].x) * st[m].y * gvv[j] + bvv[j]) + acc[ai][bj][m][n];
          acc[ai][bj][m][n] = z; s1 += z[0] + z[1] + z[2] + z[3]; s2 += z[0] * z[0] + z[1] * z[1] + z[2] * z[2] + z[3] * z[3]; }
        s1 += shfl_xor_l(s1, 16, tid & 63); s1 += shfl_xor_l(s1, 32, tid & 63); s2 += shfl_xor_l(s2, 16, tid & 63); s2 += shfl_xor_l(s2, 32, tid & 63);
        if (fq == 0) { red[(lrow * 4 + wc) * 2] = s1; red[(lrow * 4 + wc) * 2 + 1] = s2; }
      }
    }
    __syncthreads();
    if (tid < 256) { float a = 0.f, b = 0.f;
#pragma unroll
      for (int w = 0; w < 4; ++w) { a += red[(tid * 4 + w) * 2]; b += red[(tid * 4 + w) * 2 + 1]; }
      const unsigned long long rec = (unsigned long long)__float_as_uint(a) | ((unsigned long long)__float_as_uint(b) << 32);
      __hip_atomic_store((unsigned long long*)(gst + (size_t)(u.pm * 4 + u.pn) * 256 + tid), rec, __ATOMIC_RELAXED, __HIP_MEMORY_SCOPE_AGENT); }
    asm volatile("s_waitcnt vmcnt(0)" ::: "memory"); __syncthreads();
    if (tid == 0) {
      __hip_atomic_fetch_add(cnt + u.pm, 1u, __ATOMIC_RELAXED, __HIP_MEMORY_SCOPE_AGENT);
      unsigned sp = 0;
      while (__hip_atomic_load(cnt + u.pm, __ATOMIC_RELAXED, __HIP_MEMORY_SCOPE_AGENT) < 4u) { __builtin_amdgcn_s_sleep(1);
        if ((++sp & 255u) == 0u) { if (__hip_atomic_load(tmo, __ATOMIC_RELAXED, __HIP_MEMORY_SCOPE_AGENT)) break; if (sp > (1u << 20)) { atomicAdd(tmo, 1u); break; } } }
    }
    __syncthreads();
    if (tid < 256) { float a = 0.f, b = 0.f;
#pragma unroll
      for (int t = 0; t < 4; ++t) { const unsigned long long rec = __hip_atomic_load((unsigned long long*)(gst + (size_t)(u.pm * 4 + t) * 256 + tid), __ATOMIC_RELAXED, __HIP_MEMORY_SCOPE_AGENT);
        a += __uint_as_float((unsigned)rec); b += __uint_as_float((unsigned)(rec >> 32)); }
      const float mean = a * (1.f / 1024.f), var = fmaxf(b * (1.f / 1024.f) - mean * mean, 0.f);
      rst[tid * 2] = mean; rst[tid * 2 + 1] = rsqrtf(var + opaque_f(1e-5f)); }
    __syncthreads();
#pragma unroll
    for (int ai = 0; ai < 2; ++ai)
#pragma unroll
      for (int m = 0; m < 4; ++m) {
        const int lrow = wr * 64 + ai * 128 + m * 16 + fr, row = u.pm * 256 + lrow;
        const float mean = rst[lrow * 2], rstd = rst[lrow * 2 + 1]; float* orow = out + (size_t)row * 1024;
#pragma unroll
        for (int bj = 0; bj < 2; ++bj)
#pragma unroll
          for (int n = 0; n < 2; ++n) { const int col = colt + bj * 128 + 4 * n;
            *(f32x4*)(orow + col) = (acc[ai][bj][m][n] - mean) * rstd * *(const f32x4*)(pg + col) + *(const f32x4*)(pb + col); }
      }
    __syncthreads();
  }
};

namespace att {
constexpr int KVBLK = 64;
constexpr float SCALE = 0.07216878364870322f;
constexpr float THR = 8.f;
constexpr int SHM_V = 64 * 128 * 2, SHM_K = 64 * 128 * 2, SHM_R = 64 * 64 * 2;
constexpr int OFF_K = 2 * SHM_V, OFF_R = OFF_K + 2 * SHM_K, OFF_WS = OFF_R + 2 * SHM_R;
constexpr int LDQ = 1536, LDKV = 2048, LDP = NPROJ, LDO = 2048;
#define KSWZ(row, colB) ((row) * 256 + ((colB) ^ (((row) & 7) << 4)))
#define RSWZ(row, colB) ((row) * 128 + ((colB) ^ (((row) & 7) << 4)))
#define SBAR() __builtin_amdgcn_sched_barrier(0)
__device__ __forceinline__ int crow(int r, int hi) { return (r & 3) + 8 * (r >> 2) + 4 * hi; }

__device__ __forceinline__ void partialSM(f32x16& p0, f32x16& p1, float& m_reg, float& mn, float& alpha) {
  const float C = opaque_f(SCALE * 1.4426950408889634f);
  float pmax = p0[0];
#pragma unroll
  for (int r = 1; r < 16; ++r) pmax = fmaxf(pmax, p0[r]);
#pragma unroll
  for (int r = 0; r < 16; ++r) pmax = fmaxf(pmax, p1[r]);
  { auto rr = __builtin_amdgcn_permlane32_swap(__float_as_uint(pmax), __float_as_uint(pmax), false, false);
    pmax = fmaxf(__uint_as_float(rr[0]), __uint_as_float(rr[1])); }
  if (__builtin_expect(__all(pmax - m_reg <= THR / SCALE), 1)) { mn = m_reg; alpha = 1.f; }
  else { mn = fmaxf(m_reg, pmax); alpha = __builtin_amdgcn_exp2f((m_reg - mn) * C); m_reg = mn; }
  float mnC = -mn * C;
#pragma unroll
  for (int r = 0; r < 16; ++r) p0[r] = fmaf(p0[r], C, mnC);
#pragma unroll
  for (int r = 0; r < 16; ++r) p1[r] = fmaf(p1[r], C, mnC);
#pragma unroll
  for (int r = 0; r < 16; ++r) p0[r] = __builtin_amdgcn_exp2f(p0[r]);
}
__device__ __forceinline__ void finishSM(f32x16& p0, f32x16& p1, float alpha, float& l_reg, bf16x8& pa0, bf16x8& pa1, bf16x8& pa2, bf16x8& pa3) {
#pragma unroll
  for (int r = 0; r < 16; ++r) p1[r] = __builtin_amdgcn_exp2f(p1[r]);
  float ps = 0;
#pragma unroll
  for (int r = 0; r < 16; ++r) ps += p0[r];
#pragma unroll
  for (int r = 0; r < 16; ++r) ps += p1[r];
  { auto rr = __builtin_amdgcn_permlane32_swap(__float_as_uint(ps), __float_as_uint(ps), false, false);
    ps = __uint_as_float(rr[0]) + __uint_as_float(rr[1]); }
  l_reg = l_reg * alpha + ps;
#define PK4(P, BASE, OUT) do { unsigned a0 = cvt_pk_bf16(P[BASE + 0], P[BASE + 1]), a1 = cvt_pk_bf16(P[BASE + 2], P[BASE + 3]);   \
    unsigned b0 = cvt_pk_bf16(P[BASE + 4], P[BASE + 5]), b1 = cvt_pk_bf16(P[BASE + 6], P[BASE + 7]);                              \
    auto r0 = __builtin_amdgcn_permlane32_swap(a0, b0, false, false); auto r1 = __builtin_amdgcn_permlane32_swap(a1, b1, false, false); \
    u32x4 w = {r0[0], r1[0], r0[1], r1[1]}; OUT = *reinterpret_cast<bf16x8*>(&w); } while (0)
  PK4(p0, 0, pa0); PK4(p0, 8, pa1); PK4(p1, 0, pa2); PK4(p1, 8, pa3);
#undef PK4
}
template <int OFF> __device__ __forceinline__ bf16x8 ds128(int addr) {
  bf16x8 r; asm volatile("ds_read_b128 %0, %1 offset:%2" : "=&v"(r) : "v"(addr), "i"(OFF) : "memory"); return r;
}
__device__ __forceinline__ void qkt(f32x16& p0, f32x16& p1, const char* Ks, const char* Rs, const bf16x8* qr, int r32, int hi) {
  p0 = f32x16{}; p1 = f32x16{};
  const int sx = (r32 & 7) << 4, hb = hi * 16;
  const int kb = (int)(uintptr_t)Ks + r32 * 256, rb = (int)(uintptr_t)Rs + r32 * 128;
  bf16x8 b0[12], b1[12];
#define QK_LOAD(d) do { if ((d) < 8) { const int ad = kb + ((((d) * 32) + hb) ^ sx); b0[d] = ds128<0>(ad); b1[d] = ds128<8192>(ad); } \
                        else { const int ad = rb + (((((d) - 8) * 32) + hb) ^ sx); b0[d] = ds128<0>(ad); b1[d] = ds128<4096>(ad); } } while (0)
  QK_LOAD(0); QK_LOAD(1);
#pragma unroll
  for (int d = 0; d < 12; ++d) {
    if (d < 11) asm volatile("s_waitcnt lgkmcnt(2)" ::: "memory"); else asm volatile("s_waitcnt lgkmcnt(0)" ::: "memory");
    __builtin_amdgcn_sched_barrier(0);
    if (d + 2 < 12) QK_LOAD(d + 2);
    p0 = __builtin_amdgcn_mfma_f32_32x32x16_bf16(b0[d], qr[d], p0, 0, 0, 0);
    p1 = __builtin_amdgcn_mfma_f32_32x32x16_bf16(b1[d], qr[d], p1, 0, 0, 0);
  }
#undef QK_LOAD
}
__device__ __forceinline__ int v_st(int k, int c) { const int kk = (k & ~0xC) | ((k & 4) << 1) | ((k & 8) >> 1); return ((kk >> 3) * 4 + (c >> 5)) * 512 + ((kk & 7) * 32 + (c & 31)) * 2; }
__device__ __forceinline__ int v_rd_base(int lane) { return ((lane & 3) << 3) | (((lane >> 2) & 3) << 6) | (((lane >> 4) & 1) << 5) | (((lane >> 5) & 1) << 8); }
constexpr int v_rd_off(int d0, int ks, int half) { return d0 * 512 + ks * 4096 + half * 2048; }
template <int OFF> __device__ __forceinline__ s16x4 tr_read(int vb) {
  s16x4 r; asm volatile("ds_read_b64_tr_b16 %0, %1 offset:%2" : "=&v"(r) : "v"(vb), "i"(OFF) : "memory"); return r;
}
template <int D0> __device__ __forceinline__ void pv_one(f32x16& od, int vb, bf16x8 pa0, bf16x8 pa1, bf16x8 pa2, bf16x8 pa3) {
  const s16x4 l0 = tr_read<v_rd_off(D0, 0, 0)>(vb), h0 = tr_read<v_rd_off(D0, 0, 1)>(vb), l1 = tr_read<v_rd_off(D0, 1, 0)>(vb), h1 = tr_read<v_rd_off(D0, 1, 1)>(vb);
  const s16x4 l2 = tr_read<v_rd_off(D0, 2, 0)>(vb), h2 = tr_read<v_rd_off(D0, 2, 1)>(vb), l3 = tr_read<v_rd_off(D0, 3, 0)>(vb), h3 = tr_read<v_rd_off(D0, 3, 1)>(vb);
  asm volatile("s_waitcnt lgkmcnt(0)" ::: "memory"); SBAR();
#define PK(L, H) (bf16x8){L[0], L[1], L[2], L[3], H[0], H[1], H[2], H[3]}
  od = __builtin_amdgcn_mfma_f32_32x32x16_bf16(pa0, PK(l0, h0), od, 0, 0, 0);
  od = __builtin_amdgcn_mfma_f32_32x32x16_bf16(pa1, PK(l1, h1), od, 0, 0, 0);
  od = __builtin_amdgcn_mfma_f32_32x32x16_bf16(pa2, PK(l2, h2), od, 0, 0, 0);
  od = __builtin_amdgcn_mfma_f32_32x32x16_bf16(pa3, PK(l3, h3), od, 0, 0, 0);
#undef PK
}
__device__ __forceinline__ void pv_d0(f32x16* o, int vb, bf16x8 pa0, bf16x8 pa1, bf16x8 pa2, bf16x8 pa3) {
  pv_one<0>(o[0], vb, pa0, pa1, pa2, pa3); pv_one<1>(o[1], vb, pa0, pa1, pa2, pa3); pv_one<2>(o[2], vb, pa0, pa1, pa2, pa3); pv_one<3>(o[3], vb, pa0, pa1, pa2, pa3);
}

__device__ __forceinline__ void attn_unit(const bf16_t* __restrict__ Qb, const bf16_t* __restrict__ Kn, const bf16_t* __restrict__ Vh, const bf16_t* __restrict__ Kr,
                                          const bf16_t* __restrict__ Mz, bf16_t* __restrict__ Ob, int NT, char* lds, LAS unsigned char* lds3) {
  const int tid = tid_fresh(), wid = __builtin_amdgcn_readfirstlane(tid >> 6), lane = tid & 63, r32 = lane & 31, hi = lane >> 5;
  char* V_lds = lds; char* K_lds = lds + OFF_K; char* R_lds = lds + OFF_R;
  float* ws = (float*)(lds + OFF_WS) + wid * 64; float* li_l = ws; float* al_l = ws + 32;
  const float NEGBIG = opaque_f(-1e30f);
  float m_reg = NEGBIG, l_reg = 0; f32x16 o[4] = {}; bf16x8 qr[12];
  const bf16_t* Qw = Qb + (long)(wid * 32 + r32) * LDQ + hi * 8;
#pragma unroll
  for (int d0 = 0; d0 < 12; ++d0) qr[d0] = *reinterpret_cast<const bf16x8*>(Qw + d0 * 16);
  const int vb0 = (int)(uintptr_t)V_lds + v_rd_base(lane);
  unsigned gK[2], gV[2], gR;
#pragma unroll
  for (int i = 0; i < 2; ++i) {
    const int pc = wid * 2 + i;
    { const int row = pc * 4 + (lane >> 4), colB = ((lane & 15) << 4) ^ ((row & 7) << 4); gK[i] = (unsigned)(row * LDKV + (colB >> 1)); }
    { const int st = pc * 2 + (lane >> 5), kk = (st >> 2) * 8 + ((lane & 31) >> 2), c = (st & 3) * 32 + (lane & 3) * 8;
      const int k = (kk & ~0xC) | ((kk & 4) << 1) | ((kk & 8) >> 1); gV[i] = (unsigned)(k * LDKV + c); }
  }
  { const int row = wid * 8 + (lane >> 3), colB = ((lane & 7) << 4) ^ ((row & 7) << 4); gR = (unsigned)(row * LDP + (colB >> 1)); }
  LAS unsigned char* dV = lds3 + wid * 2048; LAS unsigned char* dK = lds3 + OFF_K + wid * 2048; LAS unsigned char* dR = lds3 + OFF_R + wid * 1024;
#define DMA_KR(b, k0) do { const bf16_t* _k = Kn + (long)(k0) * LDKV; const bf16_t* _r = Kr + (long)(k0) * LDP; \
    __builtin_amdgcn_global_load_lds((const unsigned*)(_k + gK[0]), (LAS unsigned*)(dK + (b) * SHM_K), 16, 0, 0); \
    __builtin_amdgcn_global_load_lds((const unsigned*)(_k + gK[1]), (LAS unsigned*)(dK + (b) * SHM_K + 1024), 16, 0, 0); \
    __builtin_amdgcn_global_load_lds((const unsigned*)(_r + gR), (LAS unsigned*)(dR + (b) * SHM_R), 16, 0, 0); } while (0)
#define DMA_V(b, k0) do { const bf16_t* _v = Vh + (long)(k0) * LDKV; \
    __builtin_amdgcn_global_load_lds((const unsigned*)(_v + gV[0]), (LAS unsigned*)(dV + (b) * SHM_V), 16, 0, 0); \
    __builtin_amdgcn_global_load_lds((const unsigned*)(_v + gV[1]), (LAS unsigned*)(dV + (b) * SHM_V + 1024), 16, 0, 0); } while (0)
#define VWAIT(n) asm volatile("s_waitcnt vmcnt(" #n ")" ::: "memory")
#define RBAR() do { asm volatile("s_waitcnt lgkmcnt(0)" ::: "memory"); __builtin_amdgcn_s_barrier(); asm volatile("" ::: "memory"); SBAR(); } while (0)
#define RESC(a) do { if (__any((a) < 1.f)) { if (hi == 0) al_l[r32] = (a); asm volatile("s_waitcnt lgkmcnt(0)" ::: "memory"); \
    _Pragma("unroll") for (int d = 0; d < 4; ++d) _Pragma("unroll") for (int r = 0; r < 16; ++r) o[d][r] *= al_l[crow(r, hi)]; } } while (0)
  f32x16 pA0, pA1, pB0, pB1; float mnA, mnB, alA, alB; bf16x8 pa0, pa1, pa2, pa3;
  __syncthreads();
  DMA_KR(0, 0); DMA_V(0, 0); DMA_KR(1, KVBLK); DMA_V(1, KVBLK);
  VWAIT(5); RBAR();
  qkt(pA0, pA1, K_lds, R_lds, qr, r32, hi);
#pragma unroll
  for (int r = 0; r < 16; ++r) pA0[r] = NEGBIG;
#pragma unroll
  for (int r = 0; r < 8; ++r) pA1[r] = NEGBIG;
  partialSM(pA0, pA1, m_reg, mnA, alA);
  VWAIT(0); RBAR();
  for (int j = 1; j + 1 < NT; j += 2) {
    DMA_KR(0, (j + 1) * KVBLK);
    SBAR(); qkt(pB0, pB1, K_lds + SHM_K, R_lds + SHM_R, qr, r32, hi);
    finishSM(pA0, pA1, alA, l_reg, pa0, pa1, pa2, pa3); SBAR();
    pv_d0(o, vb0, pa0, pa1, pa2, pa3); partialSM(pB0, pB1, m_reg, mnB, alB);
    RBAR();
    DMA_V(0, (j + 1) * KVBLK);
    RESC(alB);
    VWAIT(2); RBAR();
    const bool more = (j + 2 < NT);
    if (more) DMA_KR(1, (j + 2) * KVBLK);
    SBAR(); qkt(pA0, pA1, K_lds, R_lds, qr, r32, hi);
    finishSM(pB0, pB1, alB, l_reg, pa0, pa1, pa2, pa3); SBAR();
    pv_d0(o, vb0 + SHM_V, pa0, pa1, pa2, pa3); partialSM(pA0, pA1, m_reg, mnA, alA);
    RBAR();
    if (more) DMA_V(1, (j + 2) * KVBLK);
    RESC(alA);
    if (more) VWAIT(2); else VWAIT(0);
    RBAR();
  }
  finishSM(pA0, pA1, alA, l_reg, pa0, pa1, pa2, pa3); SBAR();
  pv_d0(o, vb0, pa0, pa1, pa2, pa3);
  if (hi == 0) li_l[r32] = l_reg; asm volatile("s_waitcnt lgkmcnt(0)" ::: "memory");
  float rli[16];
#pragma unroll
  for (int r = 0; r < 16; ++r) rli[r] = __builtin_amdgcn_rcpf(li_l[crow(r, hi)]);
  bf16_t* Ow = Ob + (long)(wid * 32) * LDO; const bf16_t* Mw = Mz + (long)(wid * 32) * LDP;
  float* wbuf = (float*)(lds + SHM_V + wid * 8192);
  u32x4 zv[2][4];
#pragma unroll
  for (int ps = 0; ps < 2; ++ps)
#pragma unroll
    for (int i = 0; i < 4; ++i) { const int c = i * 64 + lane, row = ps * 16 + (c >> 4), cc = (c & 15) * 8; zv[ps][i] = *(const u32x4*)(Mw + (long)row * LDP + cc); }
#pragma unroll
  for (int ps = 0; ps < 2; ++ps) {
#pragma unroll
    for (int rr = 0; rr < 8; ++rr) { const int r = ps * 8 + rr, lrow = crow(r, hi) - ps * 16;
#pragma unroll
      for (int d0 = 0; d0 < 4; ++d0) wbuf[lrow * 128 + d0 * 32 + r32] = o[d0][r] * rli[r]; }
#pragma unroll
    for (int i = 0; i < 4; ++i) { const int c = i * 64 + lane, lrow = c >> 4, cc = (c & 15) * 8;
      const f32x4 v0 = *(const f32x4*)(wbuf + lrow * 128 + cc), v1 = *(const f32x4*)(wbuf + lrow * 128 + cc + 4);
      const u32x4 z = zv[ps][i];
      u32x4 w;
      w[0] = cvt_pk_bf16(v0[0] * siluf_(bflo(z[0])), v0[1] * siluf_(bfhi(z[0]))); w[1] = cvt_pk_bf16(v0[2] * siluf_(bflo(z[1])), v0[3] * siluf_(bfhi(z[1])));
      w[2] = cvt_pk_bf16(v1[0] * siluf_(bflo(z[2])), v1[1] * siluf_(bfhi(z[2]))); w[3] = cvt_pk_bf16(v1[2] * siluf_(bflo(z[3])), v1[3] * siluf_(bfhi(z[3])));
      *(u32x4*)(Ow + (long)(ps * 16 + lrow) * LDO + cc) = w; }
  }
#undef DMA_KR
#undef DMA_V
#undef VWAIT
#undef RBAR
#undef RESC
}
}

__device__ void ln_h_phase(const Params& p, int c, bf16_t* hb) {
  const Chunk ck = get_chunk(p, c);
  const int lane = tid_fresh() & 63, gw = blockIdx.x * 8 + (tid_fresh() >> 6), nw = gridDim.x * 8, nrows = ck.nPp * 256;
  for (int r0 = gw * 4; r0 < nrows; r0 += nw * 4) {
    f32x4 v[4][4]; int tt[4], sq[4];
#pragma unroll
    for (int j = 0; j < 4; ++j) { const int r = r0 + j; sq[j] = r / ck.Lp; tt[j] = r % ck.Lp - 48;
      const int t = tt[j] < 0 ? 0 : tt[j];
      const float* src = (t < 16 ? p.meta + (size_t)t * DM : ck.x + ((size_t)sq[j] * ck.S + (t - 16)) * DM) + lane * 8;
      v[j][0] = *(const f32x4*)src; v[j][1] = *(const f32x4*)(src + 4); v[j][2] = *(const f32x4*)(src + 512); v[j][3] = *(const f32x4*)(src + 516); }
#pragma unroll
    for (int j = 0; j < 4; ++j) {
      bf16_t* dst = hb + (size_t)(r0 + j) * DM + lane * 8;
      if (tt[j] < 0) { *(u32x4*)dst = (u32x4){0, 0, 0, 0}; *(u32x4*)(dst + 512) = (u32x4){0, 0, 0, 0}; continue; }
      float s = 0;
#pragma unroll
      for (int i = 0; i < 4; ++i) s += v[j][i][0] + v[j][i][1] + v[j][i][2] + v[j][i][3];
      const float mu = wave_sum(s, lane) * (1.f / 1024.f);
      float q = 0;
#pragma unroll
      for (int i = 0; i < 4; ++i) { v[j][i] = v[j][i] - mu; q += v[j][i][0] * v[j][i][0] + v[j][i][1] * v[j][i][1] + v[j][i][2] * v[j][i][2] + v[j][i][3] * v[j][i][3]; }
      const float rstd = rsqrtf(wave_sum(q, lane) * (1.f / 1024.f) + opaque_f(1e-5f));
      f32x4 y[4];
#pragma unroll
      for (int i = 0; i < 4; ++i) { const int col = lane * 8 + (i >> 1) * 512 + (i & 1) * 4;
        y[i] = v[j][i] * rstd * *(const f32x4*)(p.emb_g + col) + *(const f32x4*)(p.emb_b + col); }
      *(u32x4*)dst = pack8(y[0], y[1]); *(u32x4*)(dst + 512) = pack8(y[2], y[3]);
      if (tt[j] >= 16 && lane == 0) p.lnstat[ck.crow0 + sq[j] * ck.S + (tt[j] - 16)] = make_float2(mu, rstd);
    }
  }
}
__device__ void final_ln_phase(const Params& p, int c) {
  const Chunk ck = get_chunk(p, c);
  const int lane = tid_fresh() & 63, gw = blockIdx.x * 8 + (tid_fresh() >> 6), nw = gridDim.x * 8;
  for (int r0 = gw * 4; r0 < CMAX; r0 += nw * 4) {
    f32x4 v[4][4];
#pragma unroll
    for (int j = 0; j < 4; ++j) { const float* row = p.out + (size_t)(ck.crow0 + r0 + j) * DM + lane * 4;
#pragma unroll
      for (int i = 0; i < 4; ++i) v[j][i] = *(const f32x4*)(row + i * 256); }
#pragma unroll
    for (int j = 0; j < 4; ++j) {
      float* row = p.out + (size_t)(ck.crow0 + r0 + j) * DM + lane * 4;
      float s = 0;
#pragma unroll
      for (int i = 0; i < 4; ++i) s += v[j][i][0] + v[j][i][1] + v[j][i][2] + v[j][i][3];
      const float mu = wave_sum(s, lane) * (1.f / 1024.f);
      float q = 0;
#pragma unroll
      for (int i = 0; i < 4; ++i) { v[j][i] = v[j][i] - mu; q += v[j][i][0] * v[j][i][0] + v[j][i][1] * v[j][i][1] + v[j][i][2] * v[j][i][2] + v[j][i][3] * v[j][i][3]; }
      const float rstd = rsqrtf(wave_sum(q, lane) * (1.f / 1024.f) + opaque_f(1e-5f));
#pragma unroll
      for (int i = 0; i < 4; ++i) { const int col = lane * 4 + i * 256;
        *(f32x4*)(row + i * 256) = v[j][i] * rstd * *(const f32x4*)(p.pln_g + col) + *(const f32x4*)(p.pln_b + col); }
    }
  }
}

template <class SrcFn>
__device__ void cvt_wt(const float* __restrict__ W, int ldw, int K, int N, bf16_t* __restrict__ Wt, const float* __restrict__ kscale, SrcFn src, char* lds, int ldt = 0) {
  if (ldt == 0) ldt = K;
  bf16_t* tl = (bf16_t*)lds;
  const int tid = tid_fresh(), nTn = N / 64, nTk = K / 64;
  for (int tile = blockIdx.x; tile < nTn * nTk; tile += gridDim.x) {
    const int tn = tile % nTn, tk = tile / nTn;
    { const int n = tid & 63, kk = tid >> 6; const int s = src(tn * 64 + n);
#pragma unroll
      for (int it = 0; it < 8; ++it) { const int kl = it * 8 + kk, k = tk * 64 + kl;
        float val = 0.f; if (s >= 0) { val = W[(size_t)k * ldw + s]; if (kscale) val *= kscale[k]; }
        tl[n * 66 + kl] = f2bf(val); } }
    __syncthreads();
    { const int n = tid >> 3, k8 = (tid & 7) * 8; const bf16_t* r = tl + n * 66 + k8;
      u32x4 w = {(unsigned)r[0] | ((unsigned)r[1] << 16), (unsigned)r[2] | ((unsigned)r[3] << 16), (unsigned)r[4] | ((unsigned)r[5] << 16), (unsigned)r[6] | ((unsigned)r[7] << 16)};
      *(u32x4*)(Wt + (size_t)(tn * 64 + n) * ldt + tk * 64 + k8) = w; }
    __syncthreads();
  }
}
__device__ __forceinline__ int src_w1(int n) {
  if (n < 3072) return n;
  if (n < 6144) return n - 3072 + 3808;
  if (n < 6528) return n - 6144 + 3104;
  if (n < 6784) return n - 6528 + 3488;
  if (n < 6848) { const int j = n - 6784; return 3744 + (j >> 1) + 32 * (j & 1); }
  if (n < 6864) return 3072 + (n - 6848);
  if (n < 6880) return 3088 + (n - 6864);
  return -1;
}
__device__ __forceinline__ int src_wq(int n) { const int h = n / 192, j = n % 192; if (j < 128) return n; const int jj = j - 128; return h * 192 + 128 + (jj >> 1) + 32 * (jj & 1); }
__device__ __forceinline__ int src_id(int n) { return n; }

__device__ void prep_phase(const Params& p, char* lds) {
  cvt_wt(p.w_in, 6880, 1024, NPROJ, p.W1t, nullptr, src_w1, lds);
  cvt_wt(p.w_q_b, 1536, 384, 1536, p.Wqt, p.q_g, src_wq, lds);
  cvt_wt(p.w_kv_b, 2048, 256, 2048, p.Wkvt, p.kv_g, src_id, lds);
  cvt_wt(p.w_o_gla, 1024, 1024, 1024, p.Wcat, nullptr, src_id, lds, 2048);
  cvt_wt(p.w_o_mla, 1024, 1024, 1024, p.Wcat + 1024, nullptr, src_id, lds, 2048);
  cvt_wt(p.w_out, 1024, 1024, 1024, p.Woutt, nullptr, src_id, lds);
  for (int i = blockIdx.x * 512 + tid_fresh(); i < NPOS * 32; i += gridDim.x * 512) {
    const int pos = i >> 5, f = i & 31;
    const double inv = pow(10000.0, -(double)(2 * f) / 64.0), ang = (double)pos * inv;
    p.cosT[i] = (float)cos(ang); p.sinT[i] = (float)sin(ang);
  }
}

#define SBAR_LDS() do { asm volatile("s_waitcnt lgkmcnt(0)" ::: "memory"); __builtin_amdgcn_s_barrier(); asm volatile("" ::: "memory"); } while (0)
__device__ void stats_phase(const Params& p, const Chunk& ck, char* lds) {
  const int tid = tid_fresh(), lane = tid & 63, wid = tid >> 6, nrows = ck.nPp * 256;
  { const int gw = blockIdx.x * 8 + wid, nw = gridDim.x * 8;
    for (int r0 = gw * 4; r0 < nrows; r0 += nw * 4) {
      unsigned q3[4][3], k2[4][2];
#pragma unroll
      for (int i = 0; i < 4; ++i) { const bf16_t* pr = p.proj + (size_t)(r0 + i) * NPROJ;
#pragma unroll
        for (int j = 0; j < 3; ++j) q3[i][j] = ((const unsigned*)(pr + C_CQ))[lane * 3 + j];
#pragma unroll
        for (int j = 0; j < 2; ++j) k2[i][j] = ((const unsigned*)(pr + C_CKV))[lane * 2 + j]; }
#pragma unroll
      for (int i = 0; i < 4; ++i) { float s = 0, s2 = 0;
#pragma unroll
        for (int j = 0; j < 3; ++j) { const float a = bflo(q3[i][j]), b = bfhi(q3[i][j]); s += a * a + b * b; }
#pragma unroll
        for (int j = 0; j < 2; ++j) { const float a = bflo(k2[i][j]), b = bfhi(k2[i][j]); s2 += a * a + b * b; }
        s = wave_sum(s, lane); s2 = wave_sum(s2, lane);
        if (lane == 0) { p.rstdq[r0 + i] = rsqrtf(s * (1.f / 384.f) + opaque_f(1e-6f)); p.rstdkv[r0 + i] = rsqrtf(s2 * (1.f / 256.f) + opaque_f(1e-6f)); } }
    } }
  bf16_t* glt = (bf16_t*)lds;
  float* offs = (float*)(lds + 4096);
  const int col = tid & 127, rg = tid >> 7, nunits = ck.nPp * 4 * 8;
  u32x4 stg = {0, 0, 0, 0}; float w[16]; float bias = 0.f;
  auto uload = [&](int unit) {
    const int rcn = unit >> 3, dir = (unit >> 2) & 1, head = unit & 3;
    if (tid < 256) stg = *(const u32x4*)(p.proj + (size_t)(rcn * 64 + (tid >> 2)) * NPROJ + C_GLF + (tid & 3) * 8);
    const float* wg = (dir ? p.wgb : p.wgf) + head * 128 + col;
#pragma unroll
    for (int j = 0; j < 16; ++j) w[j] = wg[j * 512];
    bias = (dir ? p.bgb : p.bgf)[head * 128 + col];
  };
  if ((int)blockIdx.x < nunits) uload(blockIdx.x);
  for (int unit = blockIdx.x; unit < nunits; unit += gridDim.x) {
    const int rcn = unit >> 3, dir = (unit >> 2) & 1, head = unit & 3;
    SBAR_LDS();
    if (tid < 256) *(u32x4*)(glt + (tid >> 2) * 32 + (tid & 3) * 8) = stg;
    float wc_[16]; const float bias_c = bias;
#pragma unroll
    for (int j = 0; j < 16; ++j) wc_[j] = w[j];
    SBAR_LDS();
    if (unit + (int)gridDim.x < nunits) uload(unit + gridDim.x);
    const int tq = (rcn * 64) % ck.Lp;
    float v[16];
#pragma unroll
    for (int i = 0; i < 16; ++i) { const int row = rg * 16 + i;
      const u32x4 x0 = *(const u32x4*)(glt + row * 32 + dir * 16), x1 = *(const u32x4*)(glt + row * 32 + dir * 16 + 8);
      float pre = bias_c;
#pragma unroll
      for (int j = 0; j < 4; ++j) { pre = fmaf(bflo(x0[j]), wc_[2 * j], pre); pre = fmaf(bfhi(x0[j]), wc_[2 * j + 1], pre); }
#pragma unroll
      for (int j = 0; j < 4; ++j) { pre = fmaf(bflo(x1[j]), wc_[8 + 2 * j], pre); pre = fmaf(bfhi(x1[j]), wc_[8 + 2 * j + 1], pre); }
      const float g = (fminf(pre, 0.f) - __logf(1.f + __expf(-fabsf(pre)))) * 0.0625f;
      v[i] = (tq + row < 48) ? 0.f : g; }
    if (dir == 0) {
#pragma unroll
      for (int i = 1; i < 16; ++i) v[i] += v[i - 1];
      offs[rg * 128 + col] = v[15];
    } else {
#pragma unroll
      for (int i = 14; i >= 0; --i) v[i] += v[i + 1];
      offs[rg * 128 + col] = v[0];
    }
    SBAR_LDS();
    float add = 0.f;
#pragma unroll
    for (int g2 = 0; g2 < 4; ++g2) { const float o = offs[g2 * 128 + col]; if (dir == 0 ? (g2 < rg) : (g2 > rg)) add += o; }
    float* dst = (dir ? p.gB : p.gF) + (size_t)(rcn * 64 + rg * 16) * 512 + head * 128 + col;
#pragma unroll
    for (int i = 0; i < 16; ++i) dst[(size_t)i * 512] = v[i] + add;
  }
  __syncthreads();
}

namespace gla {
constexpr int OFF_Q = 0, OFF_K = 16384, OFF_V = 32768, OFF_P = 45056, OFF_S = 53248, OFF_OT = 77824;
__device__ __forceinline__ int fb(int row) { return ((row & 3) << 2) | ((row >> 2) & 3); }
__device__ __forceinline__ int koff(int row, int ch) { return 256 * row + 16 * (ch ^ fb(row)); }
__device__ __forceinline__ s16x4 trr(int addr) { s16x4 r; asm volatile("ds_read_b64_tr_b16 %0, %1" : "=&v"(r) : "v"(addr) : "memory"); return r; }
#define GPK(L, H) (bf16x8){L[0], L[1], L[2], L[3], H[0], H[1], H[2], H[3]}
#define GWAITL() do { asm volatile("s_waitcnt lgkmcnt(0)" ::: "memory"); __builtin_amdgcn_sched_barrier(0); } while (0)
#define GBAR() do { asm volatile("s_waitcnt lgkmcnt(0)" ::: "memory"); __builtin_amdgcn_s_barrier(); asm volatile("" ::: "memory"); __builtin_amdgcn_sched_barrier(0); } while (0)

__device__ void item(const Params& p, const Chunk& ck, int it_, char* lds) {
  const int dvq = it_ & 3, dir = (it_ >> 2) & 1, head = (it_ >> 3) & 3, seq = it_ >> 5;
  const int tid = tid_fresh(), wid = __builtin_amdgcn_readfirstlane(tid >> 6), lane = tid & 63, r32 = lane & 31, hi = lane >> 5;
  const int ldsb = (int)(uintptr_t)lds;
  const int NC = ck.Lp / 64;
  const bf16_t* pbase = p.proj + (size_t)(seq * ck.Lp) * NPROJ;
  const float* gbase = (dir ? p.gB : p.gF) + (size_t)(seq * ck.Lp) * 512 + head * 128;
  bf16_t* obase = (dir ? p.Ob : p.Of) + (size_t)(seq * ck.S) * 1024 + head * 256 + dvq * 64;
  const int er = tid >> 4, ec = (tid & 15) * 8, vr = tid >> 3, vc = (tid & 7) * 8;
  const int midrow = dir ? 31 : 32, lastrow = dir ? 0 : 63;
  const int dt = wid >> 2, kt = wid & 3, dkl = kt * 32 + r32;
  f32x16 St = {};
  const int trow = 8 * hi + ((lane & 15) >> 2), tcol = 16 * ((lane >> 4) & 1) + 4 * (lane & 3);
  const int QS_ = 0; (void)QS_;
  const float QS = 0.08838834764831845f;
  struct Pre { u32x4 rq0, rq1, rk0, rk1, rv; f32x4 rb0a, rb0b, rb1a, rb1b, rma, rmb; float rmid, rlast; };
  Pre R0, R1;
  auto gload = [&](int chunk, Pre& r) {
    const bf16_t* pr = pbase + (size_t)(chunk * 64) * NPROJ; const float* gr = gbase + (size_t)(chunk * 64) * 512;
    r.rq0 = *(const u32x4*)(pr + (size_t)er * NPROJ + C_GQ + head * 128 + ec); r.rq1 = *(const u32x4*)(pr + (size_t)(er + 32) * NPROJ + C_GQ + head * 128 + ec);
    r.rk0 = *(const u32x4*)(pr + (size_t)er * NPROJ + C_GK + head * 128 + ec); r.rk1 = *(const u32x4*)(pr + (size_t)(er + 32) * NPROJ + C_GK + head * 128 + ec);
    r.rv = *(const u32x4*)(pr + (size_t)vr * NPROJ + C_GV + head * 256 + dvq * 64 + vc);
    r.rb0a = *(const f32x4*)(gr + (size_t)er * 512 + ec); r.rb0b = *(const f32x4*)(gr + (size_t)er * 512 + ec + 4);
    r.rb1a = *(const f32x4*)(gr + (size_t)(er + 32) * 512 + ec); r.rb1b = *(const f32x4*)(gr + (size_t)(er + 32) * 512 + ec + 4);
    r.rma = *(const f32x4*)(gr + (size_t)midrow * 512 + ec); r.rmb = *(const f32x4*)(gr + (size_t)midrow * 512 + ec + 4);
    r.rmid = gr[(size_t)midrow * 512 + dkl]; r.rlast = gr[(size_t)lastrow * 512 + dkl];
  };
  const int nsteps = dir ? NC - 1 : NC;
  gload(dir ? NC - 1 : 0, R0); gload(dir ? NC - 2 : 1, R1);
  __syncthreads();
  auto body = [&](int st, Pre& r) {
    u32x4& rq0 = r.rq0; u32x4& rq1 = r.rq1; u32x4& rk0 = r.rk0; u32x4& rk1 = r.rk1; u32x4& rv = r.rv;
    f32x4& rb0a = r.rb0a; f32x4& rb0b = r.rb0b; f32x4& rb1a = r.rb1a; f32x4& rb1b = r.rb1b; f32x4& rma = r.rma; f32x4& rmb = r.rmb; float& rmid = r.rmid; float& rlast = r.rlast;
    const int chunk = dir ? NC - 1 - st : st;
    { float e[8]; f32x4 ba = rb0a - rma, bb = rb0b - rmb;
#pragma unroll
      for (int i = 0; i < 4; ++i) { e[i] = __expf(ba[i]); e[4 + i] = __expf(bb[i]); }
      u32x4 wq, wk;
#pragma unroll
      for (int i = 0; i < 4; ++i) { const float r0 = __builtin_amdgcn_rcpf(e[2 * i]), r1 = __builtin_amdgcn_rcpf(e[2 * i + 1]);
        wq[i] = cvt_pk_bf16(bflo(rq0[i]) * QS * e[2 * i], bfhi(rq0[i]) * QS * e[2 * i + 1]); wk[i] = cvt_pk_bf16(bflo(rk0[i]) * r0, bfhi(rk0[i]) * r1); }
      *(u32x4*)(lds + OFF_Q + KSWZ(er, ec * 2)) = wq; *(u32x4*)(lds + OFF_K + koff(er, ec >> 3)) = wk;
      ba = rb1a - rma; bb = rb1b - rmb;
#pragma unroll
      for (int i = 0; i < 4; ++i) { e[i] = __expf(ba[i]); e[4 + i] = __expf(bb[i]); }
#pragma unroll
      for (int i = 0; i < 4; ++i) { const float r0 = __builtin_amdgcn_rcpf(e[2 * i]), r1 = __builtin_amdgcn_rcpf(e[2 * i + 1]);
        wq[i] = cvt_pk_bf16(bflo(rq1[i]) * QS * e[2 * i], bfhi(rq1[i]) * QS * e[2 * i + 1]); wk[i] = cvt_pk_bf16(bflo(rk1[i]) * r0, bfhi(rk1[i]) * r1); }
      *(u32x4*)(lds + OFF_Q + KSWZ(er + 32, ec * 2)) = wq; *(u32x4*)(lds + OFF_K + koff(er + 32, ec >> 3)) = wk;
      *(u32x4*)(lds + OFF_V + vr * 192 + vc * 2) = rv; }
    const float c1 = __expf(rmid), dec = __expf(rlast), c2 = __expf(rlast - rmid);
#pragma unroll
    for (int rq = 0; rq < 4; ++rq) { const int dv0 = dt * 32 + 8 * rq + 4 * hi;
      uint2 w; w.x = cvt_pk_bf16(St[4 * rq] * c1, St[4 * rq + 1] * c1); w.y = cvt_pk_bf16(St[4 * rq + 2] * c1, St[4 * rq + 3] * c1);
      *(uint2*)(lds + OFF_S + dkl * 192 + dv0 * 2) = w; }
    GBAR();
    if (st + 2 < nsteps) gload(dir ? NC - 3 - st : st + 2, r);
    f32x16 accX = {}, accT = {};
    if (wid < 4) {
      const int jt = wid >> 1, it = wid & 1;
      const int krow = jt * 32 + r32, kbase = ldsb + OFF_K + 256 * krow, kf = fb(krow);
      const int qbase = ldsb + OFF_Q + (it * 32 + r32) * 256, qs = (r32 & 7) << 4;
      bf16x8 fa[8], fq[8];
#define GP_LOAD(ks) do { fa[ks] = att::ds128<0>(kbase + 16 * ((2 * (ks) + hi) ^ kf)); fq[ks] = att::ds128<0>(qbase + ((((ks) * 32) + hi * 16) ^ qs)); } while (0)
      GP_LOAD(0);
#pragma unroll
      for (int ks = 0; ks < 8; ++ks) {
        if (ks + 1 < 8) GP_LOAD(ks + 1);
        if (ks < 7) asm volatile("s_waitcnt lgkmcnt(2)" ::: "memory"); else asm volatile("s_waitcnt lgkmcnt(0)" ::: "memory");
        __builtin_amdgcn_sched_barrier(0);
        accX = __builtin_amdgcn_mfma_f32_32x32x16_bf16(fa[ks], fq[ks], accX, 0, 0, 0); }
#undef GP_LOAD
    } else {
      const int it = (wid - 4) >> 1, dto = (wid - 4) & 1;
      const int sb = ldsb + OFF_S + trow * 192 + (dto * 32 + tcol) * 2;
      const int qbase = ldsb + OFF_Q + (it * 32 + r32) * 256, qs = (r32 & 7) << 4;
      s16x4 sl[8], sh[8]; bf16x8 fq[8];
#define GO_LOAD(ks) do { sl[ks] = trr(sb + (ks) * 16 * 192); sh[ks] = trr(sb + (ks) * 16 * 192 + 4 * 192); fq[ks] = att::ds128<0>(qbase + ((((ks) * 32) + hi * 16) ^ qs)); } while (0)
      GO_LOAD(0);
#pragma unroll
      for (int ks = 0; ks < 8; ++ks) {
        if (ks + 1 < 8) GO_LOAD(ks + 1);
        if (ks < 7) asm volatile("s_waitcnt lgkmcnt(3)" ::: "memory"); else asm volatile("s_waitcnt lgkmcnt(0)" ::: "memory");
        __builtin_amdgcn_sched_barrier(0);
        accX = __builtin_amdgcn_mfma_f32_32x32x16_bf16(fq[ks], GPK(sl[ks], sh[ks]), accX, 0, 0, 0); }
#undef GO_LOAD
    }
    {
      const int vb = ldsb + OFF_V + trow * 192 + (dt * 32 + tcol) * 2;
      const int chb = kt * 4 + 2 * ((lane >> 4) & 1) + ((lane & 3) >> 1);
      const int kb0 = ldsb + OFF_K + 256 * trow + 16 * (chb ^ fb(trow)) + 8 * (lane & 1), kb1 = ldsb + OFF_K + 256 * (trow + 4) + 16 * (chb ^ fb(trow + 4)) + 8 * (lane & 1);
      s16x4 al[4], ah[4], bl[4], bh[4];
#define GT_LOAD(ks) do { al[ks] = trr(vb + (ks) * 16 * 192); ah[ks] = trr(vb + (ks) * 16 * 192 + 4 * 192); bl[ks] = trr(kb0 + (ks) * 16 * 256); bh[ks] = trr(kb1 + (ks) * 16 * 256); } while (0)
      GT_LOAD(0);
#pragma unroll
      for (int ks = 0; ks < 4; ++ks) {
        if (ks + 1 < 4) GT_LOAD(ks + 1);
        if (ks < 3) asm volatile("s_waitcnt lgkmcnt(4)" ::: "memory"); else asm volatile("s_waitcnt lgkmcnt(0)" ::: "memory");
        __builtin_amdgcn_sched_barrier(0);
        accT = __builtin_amdgcn_mfma_f32_32x32x16_bf16(GPK(al[ks], ah[ks]), GPK(bl[ks], bh[ks]), accT, 0, 0, 0); }
#undef GT_LOAD
    }
    if (wid < 4) {
      const int jt = wid >> 1, it = wid & 1, i = it * 32 + r32;
#pragma unroll
      for (int rq = 0; rq < 4; ++rq) { const int j0 = jt * 32 + 8 * rq + 4 * hi; float v[4];
#pragma unroll
        for (int e = 0; e < 4; ++e) { const int j = j0 + e; const bool keep = dir ? (j > i) : (j <= i); v[e] = keep ? accX[4 * rq + e] : 0.f; }
        uint2 w; w.x = cvt_pk_bf16(v[0], v[1]); w.y = cvt_pk_bf16(v[2], v[3]);
        *(uint2*)(lds + OFF_P + RSWZ(i, j0 * 2)) = w; }
    }
    GBAR();
    if (wid >= 4) {
      const int it = (wid - 4) >> 1, dto = (wid - 4) & 1;
      const int vb = ldsb + OFF_V + trow * 192 + (dto * 32 + tcol) * 2;
      const int pbase_ = ldsb + OFF_P + (it * 32 + r32) * 128, ps = (r32 & 7) << 4;
      s16x4 vl[4], vh[4]; bf16x8 pa[4];
#define GB_LOAD(ks) do { vl[ks] = trr(vb + (ks) * 16 * 192); vh[ks] = trr(vb + (ks) * 16 * 192 + 4 * 192); pa[ks] = att::ds128<0>(pbase_ + ((((ks) * 32) + hi * 16) ^ ps)); } while (0)
      GB_LOAD(0);
#pragma unroll
      for (int ks = 0; ks < 4; ++ks) {
        if (ks + 1 < 4) GB_LOAD(ks + 1);
        if (ks < 3) asm volatile("s_waitcnt lgkmcnt(3)" ::: "memory"); else asm volatile("s_waitcnt lgkmcnt(0)" ::: "memory");
        __builtin_amdgcn_sched_barrier(0);
        accX = __builtin_amdgcn_mfma_f32_32x32x16_bf16(pa[ks], GPK(vl[ks], vh[ks]), accX, 0, 0, 0); }
#undef GB_LOAD
      if (chunk >= 1) {
        float* wbuf = (float*)(lds + OFF_OT + (wid - 4) * 4096);
#pragma unroll
        for (int r = 0; r < 16; ++r) wbuf[att::crow(r, hi) * 32 + r32] = accX[r];
        bf16_t* op = obase + (size_t)((chunk - 1) * 64 + it * 32) * 1024 + dto * 32;
#pragma unroll
        for (int i = 0; i < 2; ++i) { const int c = i * 64 + lane, row = c >> 2, cc = (c & 3) * 8;
          const f32x4 v0 = *(const f32x4*)(wbuf + row * 32 + cc), v1 = *(const f32x4*)(wbuf + row * 32 + cc + 4);
          *(u32x4*)(op + (size_t)row * 1024 + cc) = pack8(v0, v1); }
      }
    }
#pragma unroll
    for (int r2 = 0; r2 < 16; ++r2) St[r2] = St[r2] * dec + c2 * accT[r2];
    GBAR();
  };
  for (int st = 0; st < nsteps; st += 2) { body(st, R0); if (st + 1 < nsteps) body(st + 1, R1); }
}
#undef GPK
#undef GWAITL
#undef GBAR
}

__device__ void combine_phase(const Params& p, const Chunk& ck) {
  const int lane = tid_fresh() & 63, gw = blockIdx.x * 8 + (tid_fresh() >> 6), nw = gridDim.x * 8;
  const int dv = (lane & 15) * 16;
  f32x4 gg[4];
#pragma unroll
  for (int i = 0; i < 4; ++i) gg[i] = *(const f32x4*)(p.gla_g + dv + i * 4);
  for (int r0 = gw * 4; r0 < CMAX; r0 += nw * 4) {
    u32x4 a0[4], a1[4], b0[4], b1[4], g0[4], g1[4];
#pragma unroll
    for (int j = 0; j < 4; ++j) { const int r = r0 + j; const int prow = (r / ck.S) * ck.Lp + 64 + (r % ck.S);
      const bf16_t* a = p.Of + (size_t)r * 1024 + lane * 16; const bf16_t* b = p.Ob + (size_t)r * 1024 + lane * 16;
      const bf16_t* gr = p.proj + (size_t)prow * NPROJ + C_GR + lane * 16;
      a0[j] = *(const u32x4*)a; a1[j] = *(const u32x4*)(a + 8); b0[j] = *(const u32x4*)b; b1[j] = *(const u32x4*)(b + 8); g0[j] = *(const u32x4*)gr; g1[j] = *(const u32x4*)(gr + 8); }
#pragma unroll
    for (int j = 0; j < 4; ++j) {
      f32x4 v[4]; float s = 0;
#pragma unroll
      for (int i = 0; i < 4; ++i) { const u32x4& au = i < 2 ? a0[j] : a1[j]; const u32x4& bu = i < 2 ? b0[j] : b1[j]; const int w = (i & 1) * 2;
        v[i][0] = bflo(au[w]) + bflo(bu[w]); v[i][1] = bfhi(au[w]) + bfhi(bu[w]); v[i][2] = bflo(au[w + 1]) + bflo(bu[w + 1]); v[i][3] = bfhi(au[w + 1]) + bfhi(bu[w + 1]);
        s += v[i][0] * v[i][0] + v[i][1] * v[i][1] + v[i][2] * v[i][2] + v[i][3] * v[i][3]; }
      s += shfl_xor_l(s, 1, lane); s += shfl_xor_l(s, 2, lane); s += shfl_xor_l(s, 4, lane); s += shfl_xor_l(s, 8, lane);
      const float rs = rsqrtf(s * (1.f / 256.f) + opaque_f(1e-6f));
      f32x4 y[4];
#pragma unroll
      for (int i = 0; i < 4; ++i) { const u32x4& gu = i < 2 ? g0[j] : g1[j]; const int w = (i & 1) * 2;
        y[i][0] = v[i][0] * rs * gg[i][0] * siluf_(bflo(gu[w])); y[i][1] = v[i][1] * rs * gg[i][1] * siluf_(bfhi(gu[w]));
        y[i][2] = v[i][2] * rs * gg[i][2] * siluf_(bflo(gu[w + 1])); y[i][3] = v[i][3] * rs * gg[i][3] * siluf_(bfhi(gu[w + 1])); }
      bf16_t* d = p.Acat + (size_t)(r0 + j) * 2048 + lane * 16;
      *(u32x4*)d = pack8(y[0], y[1]); *(u32x4*)(d + 8) = pack8(y[2], y[3]);
    }
  }
}

#define XB_XCNT(j)  (256  + 64 * (j))
#define XB_XSUB(j)  (1280 + 64 * (j))
#define XB_XGEN(j)  (2304 + 64 * (j))
#define XB_TOP      3328
#define XB_TOPGEN   3392
#define XCD_BAR_WORDS 3456
#define BAR_TOTAL_WORDS (3456 + 192)
#define XB_SPIN_CAP (1u << 20)
__device__ __forceinline__ unsigned xb_ld(unsigned* p) { return __hip_atomic_load(p, __ATOMIC_RELAXED, __HIP_MEMORY_SCOPE_AGENT); }
__device__ __forceinline__ unsigned xb_add(unsigned* p, unsigned v) { return __hip_atomic_fetch_add(p, v, __ATOMIC_RELAXED, __HIP_MEMORY_SCOPE_AGENT); }
__device__ __forceinline__ unsigned xb_xcc_id() { return (unsigned)__builtin_amdgcn_s_getreg((3 << 11) | 20) & 0xFu; }
#define XB_SPIN(cond, bar) do { unsigned _sp = 0; while (cond) { __builtin_amdgcn_s_sleep(1); \
    if ((++_sp & 255u) == 0u) { if (xb_ld(&(bar)[XB_TMO])) break; if (_sp > XB_SPIN_CAP) { atomicAdd(&(bar)[XB_TMO], 1u); break; } } } } while (0)
__device__ __forceinline__ void xcd_barrier_complete(unsigned* bar, unsigned x, unsigned& nloc, unsigned& nx) {
  const unsigned G = gridDim.x;
  unsigned sum, cnt, mine, sp = 0u;
  for (;;) {
    sum = 0u; cnt = 0u; mine = 0u;
#pragma unroll
    for (unsigned j = 0; j < 16; ++j) { const unsigned c = xb_ld(&bar[XB_XCNT(j)]); sum += c; cnt += (c > 0u) ? 1u : 0u; mine = (j == x) ? c : mine; }
    if (sum == G) break;
    __builtin_amdgcn_s_sleep(1);
    if ((++sp & 255u) == 0u) { if (xb_ld(&bar[XB_TMO])) break; if (sp > XB_SPIN_CAP) { atomicAdd(&bar[XB_TMO], 1u); break; } }
  }
  nloc = mine > 0u ? mine : 1u; nx = cnt > 0u ? cnt : 1u;
}
__device__ __forceinline__ void xcd_barrier(unsigned* bar, volatile LAS unsigned* st) {
  asm volatile("s_waitcnt vmcnt(0)" ::: "memory");
  __syncthreads();
  if (tid_fresh() == 0) {
    const unsigned x = xb_xcc_id();
    __builtin_amdgcn_s_waitcnt(0);
    unsigned nloc = st[0], nx = st[1];
    if (nloc == 0u) { xcd_barrier_complete(bar, x, nloc, nx); st[0] = nloc; st[1] = nx; }
    const unsigned old = xb_add(&bar[XB_XSUB(x)], 1u);
    const unsigned gen = old / nloc;
    if (old + 1u == (gen + 1u) * nloc) {
      __builtin_amdgcn_fence(__ATOMIC_RELEASE, "agent");
      asm volatile("s_waitcnt vmcnt(0)" ::: "memory");
      const unsigned og = xb_add(&bar[XB_TOP], 1u);
      const unsigned tg = og / nx;
      if (og + 1u == (tg + 1u) * nx) xb_add(&bar[XB_TOPGEN], 1u);
      else XB_SPIN(xb_ld(&bar[XB_TOPGEN]) == tg, bar);
      __builtin_amdgcn_fence(__ATOMIC_ACQUIRE, "agent");
      xb_add(&bar[XB_XGEN(x)], 1u);
      asm volatile("s_waitcnt vmcnt(0)" ::: "memory");
    } else {
      XB_SPIN(xb_ld(&bar[XB_XGEN(x)]) == gen, bar);
      __builtin_amdgcn_fence(__ATOMIC_ACQUIRE, "agent");
      asm volatile("s_waitcnt vmcnt(0)" ::: "memory");
    }
  }
  __syncthreads();
}

#define REP_G1 1
#define REP_SYNC 1
#define REP_PREP 1
#define REP_STATS 1
#define REP_G23 1
#define REP_GLA 1
#define REP_ATT 1
#define REP_COMB 1
#define REP_G45 1
#define REP_G6 1
__device__ __forceinline__ int sfresh(int v) { asm volatile("" : "+s"(v)); return v; }
#define PHASE_VARS const Params p = load_params(); const int cc = c, G = sfresh((int)gridDim.x), bid = sfresh((int)blockIdx.x); const Chunk ck = get_chunk(p, cc);
__global__ void __launch_bounds__(512, 2) fwd_megakernel(Params p_arg) {
  extern __shared__ __attribute__((aligned(16))) char shm[];
  cg::grid_group grid = cg::this_grid();
  LAS unsigned char* lds3 = (LAS unsigned char*)shm;
  volatile LAS unsigned* xst = (volatile LAS unsigned*)(lds3 + 131072);
  if ((threadIdx.x & 63) == 0) *(volatile int*)(shm + WIDX_LDS_OFF + hw_slot() * 4) = (int)(threadIdx.x >> 6);
  { const Params p = load_params(); unsigned* bar0 = p.bar; if (threadIdx.x == 0) { xst[0] = 0u; xst[1] = 0u; (void)xb_add(&bar0[XB_XCNT(xb_xcc_id())], 1u); } }
  __syncthreads();

  for (int rep = 0; rep < REP_PREP; ++rep) { const Params p = load_params(); prep_phase(p, shm); }
  { const Params p = load_params(); ln_h_phase(p, 0, p.hbf0); }
  { const Params p = load_params(); if (p.bar == nullptr) grid.sync(); xcd_barrier(p.bar, xst); }

#pragma unroll
  for (int c = 0; c < 3; ++c) {
    for (int rep = 0; rep < REP_G1; ++rep)
    { PHASE_VARS bf16_t* hb = (cc & 1) ? p.hbf1 : p.hbf0;
      pg8::Gemm g{hb, p.W1t, 1024, 1024, 1024, ck.nPp, 27, 0, 0}; pg8::StaticOrder S; S.init(g.nM, g.nN, G, bid);
      Epi1 E{p.proj, p.cosT, p.sinT, ck.Lp}; pg8::gemm_phase(lds3, g, S, E); }
    for (int rs = 0; rs < REP_SYNC; ++rs) { const Params p = load_params(); xcd_barrier(p.bar, xst); }
    for (int rep = 0; rep < REP_STATS; ++rep)
    { PHASE_VARS stats_phase(p, ck, shm); }
    for (int rs = 0; rs < REP_SYNC; ++rs) { const Params p = load_params(); xcd_barrier(p.bar, xst); }
    for (int rep = 0; rep < REP_G23; ++rep) {
    { PHASE_VARS
      pg8::Gemm g{p.proj + C_CQ, p.Wqt, NPROJ, 384, 384, 64, 6, ck.S, ck.Lp}; pg8::StaticOrder S; S.init(g.nM, g.nN, G, bid);
      Epi2 E{p.qbuf, p.rstdq, p.cosT, p.sinT, ck.S, ck.Lp}; pg8::gemm_phase(lds3, g, S, E); }
    { PHASE_VARS
      pg8::Gemm g{p.proj + C_CKV, p.Wkvt, NPROJ, 256, 256, ck.nPp, 8, 0, 0}; pg8::StaticOrder S; S.init(g.nM, g.nN, G, (bid + 128) % G);
      Epi3 E{p.kvbuf, p.rstdkv}; pg8::gemm_phase(lds3, g, S, E); }
    }
    for (int rs = 0; rs < REP_SYNC; ++rs) { const Params p = load_params(); xcd_barrier(p.bar, xst); }
    { PHASE_VARS
      const int xcd = bid & 7, li = bid >> 3;
      const int ngrp = ck.nseq * 8, grp = xcd + 8 * (li >> 2);
      const bool has_gla = (G == 256) ? (grp < ngrp) : (bid < ck.nseq * 32);
      for (int rep = 0; rep < REP_GLA; ++rep) {
        if (G == 256) { if (has_gla) gla::item(p, ck, grp * 4 + (li & 3), shm); }
        else for (int it = bid; it < ck.nseq * 32; it += G) gla::item(p, ck, it, shm);
      }
      const int qb = ck.S / 256, nunits = ck.nseq * qb * 8, NT = ck.Lp / 64;
      for (int rep = 0; rep < REP_ATT; ++rep) {
        if (G == 256) {
          int v0, nv, vstep;
          if (cc < 2) { v0 = li; nv = 2; vstep = 32; }
          else if (li < 16) { v0 = 48 + li; nv = 1; vstep = 0; }
          else { v0 = li - 16; nv = 3; vstep = 16; }
          for (int k = 0; k < nv; ++k) {
            const int v = v0 + k * vstep, head = xcd, seq = v / qb, blk = v % qb;
            const int crow = seq * ck.S + blk * 256; const size_t prow_seq = (size_t)seq * ck.Lp, prow_q = prow_seq + 64 + blk * 256;
            att::attn_unit(p.qbuf + (size_t)crow * 1536 + head * 192, p.kvbuf + prow_seq * 2048 + head * 256, p.kvbuf + prow_seq * 2048 + head * 256 + 128,
                           p.proj + prow_seq * NPROJ + C_KR, p.proj + prow_q * NPROJ + C_MZ + head * 128, p.Acat + (size_t)crow * 2048 + 1024 + head * 128, NT, shm, lds3);
          }
        } else {
          for (int u = bid; u < nunits; u += G) {
            const int blk = u % qb, head = (u / qb) & 7, seq = u / (qb * 8);
            const int crow = seq * ck.S + blk * 256; const size_t prow_seq = (size_t)seq * ck.Lp, prow_q = prow_seq + 64 + blk * 256;
            att::attn_unit(p.qbuf + (size_t)crow * 1536 + head * 192, p.kvbuf + prow_seq * 2048 + head * 256, p.kvbuf + prow_seq * 2048 + head * 256 + 128,
                           p.proj + prow_seq * NPROJ + C_KR, p.proj + prow_q * NPROJ + C_MZ + head * 128, p.Acat + (size_t)crow * 2048 + 1024 + head * 128, NT, shm, lds3);
          }
        }
      }
      __syncthreads(); }
    for (int rs = 0; rs < REP_SYNC; ++rs) { const Params p = load_params(); xcd_barrier(p.bar, xst); }
    for (int rep = 0; rep < REP_COMB; ++rep)
    { PHASE_VARS combine_phase(p, ck); }
    if (c + 1 < 3) { const Params p = load_params(); ln_h_phase(p, c + 1, ((c + 1) & 1) ? p.hbf1 : p.hbf0); }
    for (int rs = 0; rs < REP_SYNC; ++rs) { const Params p = load_params(); xcd_barrier(p.bar, xst); }
    for (int rep = 0; rep < REP_G45; ++rep) {
    { PHASE_VARS
      pg8::Gemm g{p.Acat, p.Wcat, 2048, 2048, 2048, 64, 4, 0, 0}; pg8::StaticOrder S; S.init(g.nM, g.nN, G, bid);
      Epi45D E{p.mix, p.proj, p.b_merge, ck.S, ck.Lp}; pg8::gemm_phase(lds3, g, S, E); }
    }
    for (int rs = 0; rs < REP_SYNC; ++rs) { const Params p = load_params(); xcd_barrier(p.bar, xst); }
    { PHASE_VARS
      pg8::Gemm g{p.mix, p.Woutt, 1024, 1024, 1024, 64, 4, 0, 0}; pg8::StaticOrder S; S.init(g.nM, g.nN, G, bid);
      Epi6Ln E{cc};
      pg8::gemm_phase(lds3, g, S, E); }
  }
}

extern "C" void kernel_launch(void* const* d_in, const int* in_sizes, int n_in, void* d_out, int out_size, void* d_ws, size_t ws_size, hipStream_t stream) {
  Params p{};
  p.x_prompt = (const float*)d_in[0]; p.x_sample = (const float*)d_in[1]; p.meta = (const float*)d_in[2]; p.emb_g = (const float*)d_in[3]; p.emb_b = (const float*)d_in[4];
  p.w_in = (const float*)d_in[5]; p.b_merge = (const float*)d_in[6]; p.wgf = (const float*)d_in[7]; p.bgf = (const float*)d_in[8]; p.wgb = (const float*)d_in[9]; p.bgb = (const float*)d_in[10];
  p.gla_g = (const float*)d_in[11]; p.w_o_gla = (const float*)d_in[12]; p.q_g = (const float*)d_in[13]; p.w_q_b = (const float*)d_in[14]; p.kv_g = (const float*)d_in[15]; p.w_kv_b = (const float*)d_in[16];
  p.w_o_mla = (const float*)d_in[17]; p.w_out = (const float*)d_in[18]; p.pln_g = (const float*)d_in[19]; p.pln_b = (const float*)d_in[20];
  p.out = (float*)d_out;
  char* w = (char*)d_ws; size_t off = 0;
  auto take = [&](size_t bytes) { char* r = w + off; off += (bytes + 255) & ~(size_t)255; return r; };
  p.bar = (unsigned*)take((size_t)BAR_TOTAL_WORDS * 4);
  p.W1t = (bf16_t*)take((size_t)NPROJ * 1024 * 2); p.Wqt = (bf16_t*)take((size_t)1536 * 384 * 2); p.Wkvt = (bf16_t*)take((size_t)2048 * 256 * 2);
  p.Wcat = (bf16_t*)take((size_t)1024 * 2048 * 2); p.Woutt = (bf16_t*)take((size_t)1024 * 1024 * 2);
  p.cosT = (float*)take((size_t)NPOS * 32 * 4); p.sinT = (float*)take((size_t)NPOS * 32 * 4); p.lnstat = (float2*)take((size_t)49152 * 8); p.gst = (float2*)take((size_t)3 * 64 * 4 * 256 * 8);
  p.hbf0 = (bf16_t*)take((size_t)PMAX * 1024 * 2); p.hbf1 = (bf16_t*)take((size_t)PMAX * 1024 * 2);
  p.proj = (bf16_t*)take((size_t)PMAX * NPROJ * 2);
  p.gF = (float*)take((size_t)PMAX * 512 * 4); p.gB = (float*)take((size_t)PMAX * 512 * 4);
  p.rstdq = (float*)take((size_t)PMAX * 4); p.rstdkv = (float*)take((size_t)PMAX * 4);
  p.qbuf = (bf16_t*)take((size_t)CMAX * 1536 * 2); p.kvbuf = (bf16_t*)take((size_t)PMAX * 2048 * 2);
  p.Of = (bf16_t*)take((size_t)CMAX * 1024 * 2); p.Ob = (bf16_t*)take((size_t)CMAX * 1024 * 2);
  p.Acat = (bf16_t*)take((size_t)CMAX * 2048 * 2); p.mix = (bf16_t*)take((size_t)CMAX * 1024 * 2);
  if (off > ws_size) { fprintf(stderr, "kernel_launch: workspace too small: need %zu have %zu\n", off, ws_size); return; }
  static int grid_blocks = 0;
  if (!grid_blocks) {
    if (hipFuncSetAttribute((const void*)fwd_megakernel, hipFuncAttributeMaxDynamicSharedMemorySize, (int)LDS_BYTES) != hipSuccess) { fprintf(stderr, "kernel_launch: LDS attribute failed\n"); return; }
    int dev = 0, cus = 0, per_cu = 0;
    hipGetDevice(&dev);
    hipDeviceGetAttribute(&cus, hipDeviceAttributeMultiprocessorCount, dev);
    hipOccupancyMaxActiveBlocksPerMultiprocessor(&per_cu, fwd_megakernel, 512, LDS_BYTES);
    if (per_cu < 1) { fprintf(stderr, "kernel_launch: occupancy 0\n"); return; }
    if (cus < 256) { fprintf(stderr, "kernel_launch: needs 256 CUs, have %d\n", cus); return; }
    grid_blocks = 256;
  }
  hipMemsetAsync(p.bar, 0, (size_t)BAR_TOTAL_WORDS * 4, stream);
  void* args[] = {&p};
  hipError_t e = hipLaunchCooperativeKernel((void*)fwd_megakernel, dim3(grid_blocks), dim3(512), args, LDS_BYTES, stream);
  if (e != hipSuccess) fprintf(stderr, "cooperative launch failed: %s (grid %d)\n", hipGetErrorString(e), grid_blocks);
}
```
